# Optimizing an MI355X kernel written in HIP

```python
import jax, jax.numpy as jnp
from jax import lax
import numpy as np

D_MODEL = 2048
BATCH = 16
SEQ = 256
DEPTH = 4
DEC_BATCH = 2
DEC_SEQ = 2048
PAST_LEN = 256

GRID_W = 64
D_MIX = D_MODEL
D_A = D_MIX // 2
D_B = D_MIX - D_A
HGRN_HEAD_DIM = 128
HGRN_HEADS = D_A // HGRN_HEAD_DIM
HGRN_CHUNK = 32
N_A_PROJ = 5
POOL_WINDOWS = (2, 4, 8, 16)
POOL_GROUPS = len(POOL_WINDOWS)
POOL_GROUP_DIM = D_B // POOL_GROUPS
D_IN = N_A_PROJ * D_A + D_B
PEER_HEADS = 8
PEER_N_KEYS = 128
PEER_N_EXPERTS = PEER_N_KEYS * PEER_N_KEYS
PEER_TOPK = 16
PEER_KEY_DIM = 256
PEER_HALF = PEER_KEY_DIM // 2
PEER_BLOCK = 128
N_MOD = 6
EPS = 1e-6

kernel_name = "hymba_hgrn2_pool_peer_diffusion_step"


def rmsnorm(x, w):
    xf = x.astype(jnp.float32)
    y = xf * lax.rsqrt(jnp.mean(xf * xf, axis=-1, keepdims=True) + EPS)
    return (y * w.astype(jnp.float32)).astype(x.dtype)


def adaln(cvec, w_ada_l, b_ada_l):
    mod = jax.nn.silu(cvec) @ w_ada_l + b_ada_l
    return jnp.split(mod[:, None, :], N_MOD, axis=-1)


def gla_chunk_scan(q, k, v, logf, s0):
    b_, h_, t_, kd = q.shape
    vd = v.shape[-1]
    n = t_ // HGRN_CHUNK

    def to_chunks(a):
        return jnp.moveaxis(a.reshape(b_, h_, n, HGRN_CHUNK, a.shape[-1]), 2, 0)

    causal = jnp.tril(jnp.ones((HGRN_CHUNK, HGRN_CHUNK), dtype=bool))
    scale = kd ** -0.5

    def step(s, inp):
        qc, kc, vc, gc = inp
        bcum = jnp.cumsum(gc, axis=-2)
        o_inter = jnp.einsum('bhtk,bhkv->bhtv', qc * jnp.exp(bcum), s)
        diff = bcum[..., :, None, :] - bcum[..., None, :, :]
        decay = jnp.exp(jnp.where(causal[:, :, None], diff, -jnp.inf))
        att = jnp.einsum('bhtk,bhtsk,bhsk->bhts', qc, decay, kc)
        o = (o_inter + jnp.einsum('bhts,bhsv->bhtv', att, vc)) * scale
        blast = bcum[..., -1:, :]
        s_new = jnp.swapaxes(jnp.exp(blast), -1, -2) * s + jnp.einsum(
            'bhsk,bhsv->bhkv', kc * jnp.exp(blast - bcum), vc)
        return s_new, o

    s_fin, out = lax.scan(step, s0.astype(jnp.float32),
                          (to_chunks(q), to_chunks(k), to_chunks(v), to_chunks(logf)))
    out = jnp.moveaxis(out, 0, 2).reshape(b_, h_, t_, vd)
    return out, s_fin


def hgrn2_mixer(p_a, lb_f, lb_b, gnorm_w, s0_f, s0_b):
    b_, t_, _ = p_a.shape
    q, z_f, z_b, i, g = jnp.split(p_a.astype(jnp.float32), N_A_PROJ, axis=-1)

    def heads(a):
        return a.reshape(b_, t_, HGRN_HEADS, HGRN_HEAD_DIM).transpose(0, 2, 1, 3)

    def gates(z, lb):
        f = lb + (1.0 - lb) * jax.nn.sigmoid(z)
        return heads(1.0 - f), heads(jnp.log(f))

    qh, ih = heads(q), heads(i)
    k_f, lf_f = gates(z_f, lb_f)
    k_b, lf_b = gates(z_b, lb_b)
    o_f, s_f = gla_chunk_scan(qh, k_f, ih, lf_f, s0_f)

    def rev(a):
        return jnp.flip(a, axis=2)

    o_b, s_b = gla_chunk_scan(rev(qh), rev(k_b), rev(ih), rev(lf_b), s0_b)
    o = (o_f + rev(o_b)).transpose(0, 2, 1, 3)
    o = o * lax.rsqrt(jnp.mean(o * o, axis=-1, keepdims=True) + EPS) \
        * gnorm_w.astype(jnp.float32).reshape(HGRN_HEADS, HGRN_HEAD_DIM)
    o = o.reshape(b_, t_, D_A) * jax.nn.silu(g)
    return o.astype(p_a.dtype), s_f, s_b


def multiscale_pool(u):
    L = u.shape[-2]
    uf = u.astype(jnp.float32)
    csum = jnp.cumsum(uf, axis=-2)
    csum = jnp.concatenate([jnp.zeros_like(csum[..., :1, :]), csum], axis=-2)
    pos = jnp.arange(L)
    outs = []
    for gi, w in enumerate(POOL_WINDOWS):
        sl = slice(gi * POOL_GROUP_DIM, (gi + 1) * POOL_GROUP_DIM)
        lo = jnp.clip(pos - w // 2, 0, L)
        hi = jnp.clip(pos + w // 2, 0, L)
        cg = csum[..., sl]
        total = jnp.take(cg, hi, axis=-2) - jnp.take(cg, lo, axis=-2)
        count = (hi - lo).astype(jnp.float32)[:, None]
        outs.append(total / count - uf[..., sl])
    return jnp.concatenate(outs, axis=-1).astype(u.dtype)


def pool_mixer(u, w_pool_l, pool_scale_l, grid_rows):
    b_, t_, c_ = u.shape
    if grid_rows is not None:
        y = multiscale_pool(u.reshape(b_, grid_rows, GRID_W, c_)).reshape(b_, t_, c_)
    else:
        y = multiscale_pool(u)
    y = jnp.einsum('btgc,gcd->btgd', y.reshape(b_, t_, POOL_GROUPS, POOL_GROUP_DIM), w_pool_l)
    return y.reshape(b_, t_, c_) * pool_scale_l


def peer(h, w_query_l, sub_keys_l, u_l, v_l):
    shp = h.shape
    xt = h.reshape(-1, PEER_BLOCK, D_MODEL)

    def block(xb):
        q = (xb @ w_query_l).reshape(PEER_BLOCK, PEER_HEADS, 2, PEER_HALF)
        s = jnp.einsum('thpk,hpnk->thpn', q, sub_keys_l).astype(jnp.float32)
        s1, i1 = lax.top_k(s[:, :, 0], PEER_TOPK)
        s2, i2 = lax.top_k(s[:, :, 1], PEER_TOPK)
        cand = (s1[..., :, None] + s2[..., None, :]).reshape(PEER_BLOCK, PEER_HEADS, PEER_TOPK * PEER_TOPK)
        cidx = (i1[..., :, None] * PEER_N_KEYS + i2[..., None, :]).reshape(PEER_BLOCK, PEER_HEADS, PEER_TOPK * PEER_TOPK)
        top_s, pos = lax.top_k(cand, PEER_TOPK)
        idx = jnp.take_along_axis(cidx, pos, axis=-1)
        gate = jax.nn.softmax(top_s, axis=-1)
        act = jax.nn.gelu(jnp.einsum('td,thed->the', xb, u_l[idx]), approximate=False)
        return jnp.einsum('the,thed->td', (gate * act).astype(xb.dtype), v_l[idx])

    return lax.map(block, xt).reshape(shp)


def trunk_layer(x, cvec, s0_f, s0_b, grid_rows, lb_f, lb_b, w_ada_l, b_ada_l, norm_w_l,
                w_in_l, gnorm_w_l, w_pool_l, pool_scale_l, w_out_l, w_query_l, sub_keys_l, u_l, v_l):
    sh1, sc1, g1, sh2, sc2, g2 = adaln(cvec, w_ada_l, b_ada_l)
    h = rmsnorm(x, norm_w_l[0]) * (1.0 + sc1) + sh1
    p = h @ w_in_l
    o_a, s_f, s_b = hgrn2_mixer(p[..., :N_A_PROJ * D_A], lb_f, lb_b, gnorm_w_l, s0_f, s0_b)
    o_b = pool_mixer(p[..., N_A_PROJ * D_A:], w_pool_l, pool_scale_l, grid_rows)
    x = x + g1 * (jnp.concatenate([o_a, o_b], axis=-1) @ w_out_l)
    h = rmsnorm(x, norm_w_l[1]) * (1.0 + sc2) + sh2
    x = x + g2 * peer(h, w_query_l, sub_keys_l, u_l, v_l)
    return x, s_f, s_b


def setup_inputs(seed: int = 0) -> dict:
    key = jax.random.key(seed)
    ks = jax.random.split(key, 20)

    def nrm(k, shape, s):
        return jax.random.normal(k, shape, jnp.float32) * s

    st = (HGRN_HEADS, HGRN_HEAD_DIM, HGRN_HEAD_DIM)
    return {
        "x_prompt": nrm(ks[0], (BATCH, SEQ, D_MODEL), 1.0),
        "x_sample": nrm(ks[1], (DEC_BATCH, DEC_SEQ, D_MODEL), 1.0),
        "state_hgrn": nrm(ks[2], (DEC_BATCH, DEPTH, 2) + st, 0.5),
        "c": nrm(ks[3], (DEC_BATCH, D_MODEL), 1.0),
        "c_ctx": nrm(ks[4], (D_MODEL,), 1.0),
        "w_ada": nrm(ks[5], (DEPTH, D_MODEL, N_MOD * D_MODEL), 0.5 * D_MODEL ** -0.5),
        "b_ada": nrm(ks[6], (DEPTH, N_MOD * D_MODEL), 0.02),
        "norm_w": 1.0 + nrm(ks[7], (DEPTH, 2, D_MODEL), 0.05),
        "w_in": nrm(ks[8], (DEPTH, D_MODEL, D_IN), D_MODEL ** -0.5),
        "lower_bounds": nrm(ks[9], (2, DEPTH, D_A), 0.5),
        "hgrn_norm_w": 1.0 + nrm(ks[10], (DEPTH, D_A), 0.05),
        "w_pool": nrm(ks[11], (DEPTH, POOL_GROUPS, POOL_GROUP_DIM, POOL_GROUP_DIM), POOL_GROUP_DIM ** -0.5),
        "pool_scale": 1.0 + nrm(ks[12], (DEPTH, D_B), 0.05),
        "w_out": nrm(ks[13], (DEPTH, D_MODEL, D_MODEL), D_MODEL ** -0.5),
        "w_query": nrm(ks[14], (DEPTH, D_MODEL, PEER_HEADS * PEER_KEY_DIM), D_MODEL ** -0.5),
        "sub_keys": nrm(ks[15], (DEPTH, PEER_HEADS, 2, PEER_N_KEYS, PEER_HALF), PEER_HALF ** -0.5),
        "expert_u": nrm(ks[16], (DEPTH, PEER_N_EXPERTS, D_MODEL), D_MODEL ** -0.5),
        "expert_v": nrm(ks[17], (DEPTH, PEER_N_EXPERTS, D_MODEL), 0.25),
        "final_norm_w": 1.0 + nrm(ks[18], (D_MODEL,), 0.05),
    }


def reference(x_prompt, x_sample, state_hgrn, c, c_ctx, w_ada, b_ada, norm_w, w_in, lower_bounds,
              hgrn_norm_w, w_pool, pool_scale, w_out, w_query, sub_keys, expert_u, expert_v,
              final_norm_w):
    lb_soft = jax.nn.softmax(lower_bounds.astype(jnp.float32), axis=1)
    lb = jnp.cumsum(lb_soft, axis=1) - lb_soft[:, :1]
    grid_rows = x_sample.shape[1] // GRID_W
    zero_state = jnp.zeros((x_prompt.shape[0], HGRN_HEADS, HGRN_HEAD_DIM, HGRN_HEAD_DIM), jnp.float32)
    xp, xs = x_prompt, x_sample
    ctx_states = []
    for l in range(DEPTH):
        xp, s_f, s_b = trunk_layer(xp, c_ctx[None, :], zero_state, zero_state, None, lb[0, l], lb[1, l],
                                   w_ada[l], b_ada[l], norm_w[l], w_in[l], hgrn_norm_w[l], w_pool[l],
                                   pool_scale[l], w_out[l], w_query[l], sub_keys[l], expert_u[l], expert_v[l])
        ctx_states.append(jnp.stack([s_f, s_b], axis=1))
        xs, _, _ = trunk_layer(xs, c, state_hgrn[:, l, 0], state_hgrn[:, l, 1], grid_rows, lb[0, l], lb[1, l],
                               w_ada[l], b_ada[l], norm_w[l], w_in[l], hgrn_norm_w[l], w_pool[l],
                               pool_scale[l], w_out[l], w_query[l], sub_keys[l], expert_u[l], expert_v[l])
    y_prompt = rmsnorm(xp, final_norm_w)
    y_sample = rmsnorm(xs, final_norm_w)
    state_hgrn_new = jnp.stack(ctx_states, axis=1).astype(x_prompt.dtype)
    return (y_prompt, y_sample, state_hgrn_new)
```

```cpp
#include <hip/hip_runtime.h>
#include <cstdio>
#include <cstdint>

#ifndef MK_ONE_LAUNCH
#define MK_ONE_LAUNCH 1
#endif
#ifndef MK_KIND_MASK
#define MK_KIND_MASK 0x3ff
#endif
#define KIND_ON(k) (((MK_KIND_MASK) >> (k)) & 1)
#ifndef MK_REPEAT_MASK
#define MK_REPEAT_MASK 0
#endif
#define NREP(k) (1 + (((MK_REPEAT_MASK) >> (k)) & 1))

#define DI __device__ __forceinline__
#define LAS __attribute__((address_space(3)))

typedef unsigned short bf16_t;
typedef short bf16x8 __attribute__((ext_vector_type(8)));
typedef float f32x2 __attribute__((ext_vector_type(2)));
typedef float f32x4 __attribute__((ext_vector_type(4)));
typedef float f32x16 __attribute__((ext_vector_type(16)));
typedef unsigned u32x2 __attribute__((ext_vector_type(2)));
typedef unsigned u32x4 __attribute__((ext_vector_type(4)));
typedef unsigned u32x6 __attribute__((ext_vector_type(6)));
typedef float f32x32 __attribute__((ext_vector_type(32)));
typedef _Float16 h2v __attribute__((ext_vector_type(2)));
typedef _Float16 h32v __attribute__((ext_vector_type(32)));
typedef __bf16 bf16x2_t __attribute__((ext_vector_type(2)));

constexpr int D = 2048, NTOK = 8192, TP = 4096, DIN = 6144, NMOD = 12288, NEXP = 16384;
constexpr float EPS = 1e-6f;
constexpr int NPHASE = 38;
constexpr int ROWB = 1152;

constexpr size_t WS_CTL = 0;
constexpr size_t WS_MOD = 65536;
constexpr size_t WS_LB = WS_MOD + (size_t)4 * 3 * 12288 * 4;
constexpr size_t WS_WIN = WS_LB + (size_t)2 * 4 * 1024 * 4;
constexpr size_t WS_WOUT = WS_WIN + (size_t)4 * 6144 * 2048 * 2;
constexpr size_t WS_WQ = WS_WOUT + (size_t)4 * 2048 * 2048 * 2;
constexpr size_t WS_WINU = WS_WQ + (size_t)4 * 2048 * 2048 * 2;
constexpr size_t WS_WPOOL = WS_WINU + (size_t)16 * 2048 * 256 * 2;
constexpr size_t WS_KEYS = WS_WPOOL + (size_t)16 * 256 * 256 * 2;
constexpr size_t WS_UTAB = WS_KEYS + (size_t)4 * 8 * 2 * 128 * 128 * 2;
constexpr size_t WS_VTAB = WS_UTAB + (size_t)4 * 16384 * 2048;
constexpr size_t WS_X = WS_VTAB + (size_t)4 * 16384 * 2048;
constexpr size_t WS_HB = WS_X + (size_t)8192 * 2048 * 4;
constexpr size_t WS_P = WS_HB + (size_t)8192 * 2048 * 2;
constexpr size_t WS_OF = WS_P + (size_t)8192 * 6144 * 2;
constexpr size_t WS_OB = WS_OF + (size_t)8192 * 1024 * 4;
constexpr size_t WS_CAT = WS_OB + (size_t)8192 * 1024 * 4;
constexpr size_t WS_Q = WS_CAT + (size_t)8192 * 2048 * 2;
constexpr size_t WS_SELI = WS_Q + (size_t)8192 * 2048 * 2;
constexpr size_t WS_SELG = WS_SELI + (size_t)8192 * 128 * 4;
constexpr size_t WS_MODP = WS_SELG + (size_t)8192 * 128 * 4;
constexpr size_t WS_USC = WS_MODP + (size_t)4 * 4 * 3 * 12288 * 4;
constexpr size_t WS_VSC = WS_USC + (size_t)4 * 16384 * 4;
constexpr size_t WS_QH = WS_VSC + (size_t)4 * 16384 * 4;
constexpr size_t WS_SSEG = WS_QH + (size_t)2 * 4096 * 1024 * 2;
constexpr size_t WS_DSEG = WS_SSEG + (size_t)256 * 16384 * 4;
constexpr size_t WS_END = WS_DSEG + (size_t)256 * 128 * 4;
constexpr size_t MODP_STRIDE = (size_t)4 * 3 * 12288;

constexpr int LDS_BYTES = 155648;
constexpr int MISC_OFF = LDS_BYTES - 256;

DI unsigned pk_bf16(float lo, float hi) { f32x2 v = {lo, hi}; bf16x2_t b = __builtin_convertvector(v, bf16x2_t); return __builtin_bit_cast(unsigned, b); }
DI float bf_lo(unsigned x) { return __uint_as_float(x << 16); }
DI float bf_hi(unsigned x) { return __uint_as_float(x & 0xffff0000u); }
template <int M> DI float xshfl(float v) {
    if constexpr (M < 32) return __int_as_float(__builtin_amdgcn_ds_swizzle(__float_as_int(v), (M << 10) | 0x1f));
    else { unsigned z = 0u; asm volatile("; rebuilt at each use, never kept" : "+v"(z)); const unsigned ad = (__builtin_amdgcn_mbcnt_hi(~0u, __builtin_amdgcn_mbcnt_lo(~0u, z)) ^ 32u) << 2; return __int_as_float(__builtin_amdgcn_ds_bpermute((int)ad, __float_as_int(v))); }
}
DI float wave_sum(float v) { v += xshfl<32>(v); v += xshfl<16>(v); v += xshfl<8>(v); v += xshfl<4>(v); v += xshfl<2>(v); v += xshfl<1>(v); return v; }
DI float fdot2(unsigned a, unsigned b, float c) { return __builtin_amdgcn_fdot2_f32_bf16(__builtin_bit_cast(bf16x2_t, a), __builtin_bit_cast(bf16x2_t, b), c, false); }
DI float silu_f(float x) { return x / (1.f + __expf(-x)); }
#define MFMA32(a, b, c) __builtin_amdgcn_mfma_f32_32x32x16_bf16((a), (b), (c), 0, 0, 0)
DI int fresh_tid(const int wave_s) { unsigned z = 0u; asm volatile("; fresh lane id" : "+v"(z)); const int t = (int)__builtin_amdgcn_mbcnt_hi(~0u, __builtin_amdgcn_mbcnt_lo(~0u, z)); return (wave_s << 6) | t; }
DI int crow(int i, int hh) { return (i & 3) + 8 * (i >> 2) + 4 * hh; }

#define XB_TMO      128
#define XB_XCNT(j)  (256  + 64 * (j))
#define XB_XSUB(j)  (1280 + 64 * (j))
#define XB_XGEN(j)  (2304 + 64 * (j))
#define XB_TOP      3328
#define XB_TOPGEN   3392
#define XCD_BAR_WORDS 3456
#define XB_SPIN_CAP (1u << 18)

__device__ __forceinline__ unsigned xb_ld(unsigned* p)              { return __hip_atomic_load(p, __ATOMIC_RELAXED, __HIP_MEMORY_SCOPE_AGENT); }
__device__ __forceinline__ unsigned xb_add(unsigned* p, unsigned v) { return __hip_atomic_fetch_add(p, v, __ATOMIC_RELAXED, __HIP_MEMORY_SCOPE_AGENT); }
__device__ __forceinline__ unsigned xb_xcc_id() { return (unsigned)__builtin_amdgcn_s_getreg((3 << 11) | 20) & 0xFu; }
#define XB_SPIN(cond, bar) do { unsigned _sp = 0; while (cond) { __builtin_amdgcn_s_sleep(1); \
    if ((++_sp & 255u) == 0u) { if (xb_ld(&(bar)[XB_TMO])) break; if (_sp > XB_SPIN_CAP) { atomicAdd(&(bar)[XB_TMO], 1u); break; } } } } while (0)

struct XcdBarrier {
    unsigned* bar; unsigned x;
    volatile LAS unsigned* st;
};
__device__ __forceinline__ XcdBarrier xcd_barrier_post(unsigned* bar, volatile LAS unsigned* st) {
    XcdBarrier b; b.bar = bar; b.x = xb_xcc_id(); b.st = st;
    if (threadIdx.x == 0) (void)xb_add(&bar[XB_XCNT(b.x)], 1u);
    return b;
}
__device__ __forceinline__ void xcd_barrier_complete(unsigned* bar, unsigned x, unsigned& nloc, unsigned& nx) {
    const unsigned G = gridDim.x * gridDim.y * gridDim.z;
    unsigned sum, cnt, mine, sp = 0u;
    for (;;) {
        sum = 0u; cnt = 0u; mine = 0u;
#pragma unroll
        for (unsigned j = 0; j < 16; ++j) { const unsigned c = xb_ld(&bar[XB_XCNT(j)]); sum += c; cnt += (c > 0u) ? 1u : 0u; mine = (j == x) ? c : mine; }
        if (sum == G) break;
        __builtin_amdgcn_s_sleep(1);
        if ((++sp & 255u) == 0u) { if (xb_ld(&bar[XB_TMO])) break; if (sp > XB_SPIN_CAP) { atomicAdd(&bar[XB_TMO], 1u); break; } }
    }
    nloc = mine > 0u ? mine : 1u; nx = cnt > 0u ? cnt : 1u;
}
__device__ __forceinline__ void xcd_barrier(const XcdBarrier& b) {
    asm volatile("s_waitcnt vmcnt(0)" ::: "memory");
    __syncthreads();
    if (threadIdx.x == 0) {
        unsigned* bar = b.bar;
        __builtin_amdgcn_s_waitcnt(0);
        unsigned nloc = b.st[0], nx = b.st[1];
        if (nloc == 0u) { xcd_barrier_complete(bar, b.x, nloc, nx); b.st[0] = nloc; b.st[1] = nx; }
        const unsigned old = xb_add(&bar[XB_XSUB(b.x)], 1u);
        const unsigned gen = old / nloc;
        if (old + 1u == (gen + 1u) * nloc) {
            __builtin_amdgcn_fence(__ATOMIC_RELEASE, "agent");
            asm volatile("s_waitcnt vmcnt(0)" ::: "memory");
            const unsigned og = xb_add(&bar[XB_TOP], 1u);
            const unsigned tg = og / nx;
            if (og + 1u == (tg + 1u) * nx) xb_add(&bar[XB_TOPGEN], 1u);
            else XB_SPIN(xb_ld(&bar[XB_TOPGEN]) == tg, bar);
            __builtin_amdgcn_fence(__ATOMIC_ACQUIRE, "agent");
            xb_add(&bar[XB_XGEN(b.x)], 1u);
            asm volatile("s_waitcnt vmcnt(0)" ::: "memory");
        } else {
            XB_SPIN(xb_ld(&bar[XB_XGEN(b.x)]) == gen, bar);
            __builtin_amdgcn_fence(__ATOMIC_ACQUIRE, "agent");
            asm volatile("s_waitcnt vmcnt(0)" ::: "memory");
        }
    }
    __syncthreads();
}

namespace pg8 {
constexpr int BM = 256, BK = 64, HALF = 128, HTB = HALF * BK * 2, STAGE_BYTES = 8 * HTB, NXCD = 8, WGM = 8;
__host__ __device__ __forceinline__ int lds_byte(int r, int c) { const int st = (r >> 4) * 2 + (c >> 5), rr = r & 15, cc = c & 31, ob = rr * 64 + cc * 2; return st * 1024 + (ob ^ (((ob >> 9) & 1) << 5)); }
__host__ __device__ __forceinline__ void stage_rc(int b, int& R, int& C) { const int st = b / 1024, sb = b % 1024, swz = sb ^ (((sb >> 9) & 1) << 5); R = (st >> 1) * 16 + swz / 64; C = (st & 1) * 32 + (swz % 64) / 2; }
__host__ __device__ __forceinline__ int perm32(int rho) { const int n = rho >> 4, i = rho & 15; return 8 * (i >> 2) + 4 * n + (i & 3); }

struct Unit { int pm, pn; };
struct Gemm { const bf16_t* A; const bf16_t* Bt; int M, N, K, lda, ldb; };

struct StaticOrder {
    int nM, nN, nwg, G, c;
    __host__ __device__ void init(int M, int N, int G_, int c_) { nM = M / BM; nN = N / BM; nwg = nM * nN; G = G_; c = c_; }
    __host__ __device__ bool next(int i, Unit& u) const {
        const long L = (long)i * G + c; if (L >= nwg) return false;
        int wgid = (int)L; { const int q = nwg / NXCD, r = nwg % NXCD, xcd = wgid % NXCD, off = wgid / NXCD; wgid = (xcd < r ? xcd * (q + 1) : r * (q + 1) + (xcd - r) * q) + off; }
        const int nig = WGM * nN, gid = wgid / nig, fm = gid * WGM, gsz = (nM - fm) < WGM ? (nM - fm) : WGM;
        u.pm = fm + ((wgid % nig) % gsz); u.pn = (wgid % nig) / gsz; return true;
    }
    __device__ __forceinline__ void a_ready(const Unit&) const {}
    __device__ __forceinline__ void done(const Unit&) const {}
};
struct PoolFoldOrder {
    int G, c;
    __device__ bool next(int i, Unit& u) const { const int L = i * G + c; if (L >= 128) return false; u.pm = L >> 3; u.pn = L; return true; }
    __device__ __forceinline__ void a_ready(const Unit&) const {}
    __device__ __forceinline__ void done(const Unit&) const {}
};

struct EpiBf16 {
    static constexpr bool PERM = true, AFTER_DRAIN = false;
    bf16_t* O; int ldc;
    __device__ __forceinline__ void operator()(const f32x4 (&acc)[2][2][4][2], const Unit& u, int wr, int wc, int fr, int fq) const {
        const int row0 = u.pm * BM + wr * 64 + fr; const int col0 = u.pn * BM + wc * 32 + 8 * fq;
#pragma unroll
        for (int ai = 0; ai < 2; ++ai)
#pragma unroll
            for (int m = 0; m < 4; ++m) { bf16_t* rowp = O + (size_t)(row0 + ai * HALF + m * 16) * ldc + col0;
#pragma unroll
                for (int bj = 0; bj < 2; ++bj) { const f32x4 v0 = acc[ai][bj][m][0], v1 = acc[ai][bj][m][1];
                    u32x4 w; w.x = pk_bf16(v0[0], v0[1]); w.y = pk_bf16(v0[2], v0[3]); w.z = pk_bf16(v1[0], v1[1]); w.w = pk_bf16(v1[2], v1[3]);
                    *(u32x4*)(rowp + bj * HALF) = w; } }
    }
};
struct EpiPoolFold {
    static constexpr bool PERM = true, AFTER_DRAIN = false;
    bf16_t* WIN;
    __device__ __forceinline__ void operator()(const f32x4 (&acc)[2][2][4][2], const Unit& u, int wr, int wc, int fr, int fq) const {
        const int lg = u.pm, l = lg >> 2, g = lg & 3, kt = u.pn & 7;
        bf16_t* base = WIN + ((size_t)l * 6144 + 5120 + g * 256) * 2048 + kt * 256;
        const int row0 = wr * 64 + fr, col0 = wc * 32 + 8 * fq;
#pragma unroll
        for (int ai = 0; ai < 2; ++ai)
#pragma unroll
            for (int m = 0; m < 4; ++m) { bf16_t* rowp = base + (size_t)(row0 + ai * HALF + m * 16) * 2048 + col0;
#pragma unroll
                for (int bj = 0; bj < 2; ++bj) { const f32x4 v0 = acc[ai][bj][m][0], v1 = acc[ai][bj][m][1];
                    u32x4 w; w.x = pk_bf16(v0[0], v0[1]); w.y = pk_bf16(v0[2], v0[3]); w.z = pk_bf16(v1[0], v1[1]); w.w = pk_bf16(v1[2], v1[3]);
                    *(u32x4*)(rowp + bj * HALF) = w; } }
    }
};
struct EpiRes {
    static constexpr bool PERM = false, AFTER_DRAIN = false;
    const float* xin_p; const float* xin_s; float* xout; const float* gate;
    __device__ __forceinline__ void operator()(const f32x4 (&acc)[2][2][4][2], const Unit& u, int wr, int wc, int fr, int fq) const {
        const int row0 = u.pm * BM + wr * 64 + fr, col0 = u.pn * BM + wc * 32 + 4 * fq;
        const int grp = (u.pm < 16) ? 0 : 1 + ((u.pm - 16) >> 3);
        const float* gp = gate + (size_t)grp * 12288 + col0;
        f32x4 gv[2][2];
#pragma unroll
        for (int bj = 0; bj < 2; ++bj)
#pragma unroll
            for (int n = 0; n < 2; ++n) gv[bj][n] = *(const f32x4*)(gp + bj * HALF + n * 16);
#pragma unroll
        for (int ai = 0; ai < 2; ++ai)
#pragma unroll
            for (int m = 0; m < 4; ++m) { const int row = row0 + ai * HALF + m * 16;
                const float* xi = (row < TP ? xin_p + (size_t)row * D : xin_s + (size_t)(row - TP) * D) + col0; float* xo = xout + (size_t)row * D + col0;
#pragma unroll
                for (int bj = 0; bj < 2; ++bj)
#pragma unroll
                    for (int n = 0; n < 2; ++n) { const f32x4 xv = *(const f32x4*)(xi + bj * HALF + n * 16); *(f32x4*)(xo + bj * HALF + n * 16) = xv + gv[bj][n] * acc[ai][bj][m][n]; } }
    }
};

template <class Epi, class Sched>
__device__ __forceinline__ void gemm_phase(LAS unsigned char* lds, const Gemm g, const Sched& S, const Epi& E, const int wave_s) {
    const int tid = fresh_tid(wave_s), wid = __builtin_amdgcn_readfirstlane(tid >> 6), lane = tid & 63, wr = wid >> 2, wc = wid & 3, fr = lane & 15, fq = lane >> 4;
    const int K = g.K, nt = K / BK;
    unsigned voffA[2], voffB[2];
#pragma unroll
    for (int i = 0; i < 2; ++i) { int R, C; stage_rc(tid * 16 + i * 8192, R, C); const int Rb = Epi::PERM ? ((R & ~31) + perm32(R & 31)) : R;
        voffA[i] = (unsigned)(R * g.lda + C) * 2u; voffB[i] = (unsigned)(Rb * g.ldb + C) * 2u; }
    const size_t kstep = (size_t)(BK * 2);
    const size_t hstepA = (size_t)HALF * g.lda * 2, hstepB = (size_t)HALF * g.ldb * 2;
    const size_t tstepA = 2 * hstepA, tstepB = 2 * hstepB;
    const unsigned ldsw = (unsigned)wid * 1024u;
    const int aoff = lds_byte(wr * 64 + fr, fq * 8), boff = lds_byte(wc * 32 + fr, fq * 8);
#define PG8_SA(b, h) (((b) * 2 + (h)) * HTB)
#define PG8_SB(b, h) ((4 + (b) * 2 + (h)) * HTB)
#define PG8_STAGE(bufoff, gbase, voff) do { _Pragma("unroll") for (int _i = 0; _i < 2; ++_i) \
        __builtin_amdgcn_global_load_lds((const unsigned*)((const char*)(gbase) + (voff)[_i]), (LAS unsigned*)(lds + (bufoff) + ldsw + _i * 8192), 16, 0, 0); } while (0)
#define PG8_LDA(dst, b, h) do { _Pragma("unroll") for (int m = 0; m < 4; ++m) _Pragma("unroll") for (int k = 0; k < 2; ++k) dst[m][k] = *(const LAS bf16x8*)(lds + PG8_SA(b, h) + aoff + m * 2048 + k * 1024); } while (0)
#define PG8_LDB(dst, b, h) do { _Pragma("unroll") for (int n = 0; n < 2; ++n) _Pragma("unroll") for (int k = 0; k < 2; ++k) dst[n][k] = *(const LAS bf16x8*)(lds + PG8_SB(b, h) + boff + n * 2048 + k * 1024); } while (0)
#define PG8_MMA(ai, bj, At, Bt) do { __builtin_amdgcn_s_setprio(1); _Pragma("unroll") for (int m = 0; m < 4; ++m) _Pragma("unroll") for (int n = 0; n < 2; ++n) _Pragma("unroll") for (int k = 0; k < 2; ++k) \
        acc[ai][bj][m][n] = __builtin_amdgcn_mfma_f32_16x16x32_bf16(Bt[n][k], At[m][k], acc[ai][bj][m][n], 0, 0, 0); __builtin_amdgcn_s_setprio(0); } while (0)
#define PG8_WAIT_V(n) asm volatile("s_waitcnt vmcnt(" #n ")" ::: "memory")
#define PG8_WAIT_L(n) asm volatile("s_waitcnt lgkmcnt(" #n ")" ::: "memory")
#define PG8_BAR __builtin_amdgcn_s_barrier()
#define PG8_SCHED __builtin_amdgcn_sched_barrier(0)
    Unit cur, nxt; int ui = 0;
    if (!S.next(0, cur)) return;
    f32x4 acc[2][2][4][2];
#pragma unroll
    for (int a = 0; a < 2; ++a)
#pragma unroll
        for (int b = 0; b < 2; ++b)
#pragma unroll
            for (int m = 0; m < 4; ++m)
#pragma unroll
                for (int n = 0; n < 2; ++n) acc[a][b][m][n] = (f32x4){0.f, 0.f, 0.f, 0.f};
    bf16x8 At[4][2], B0[2][2], B1[2][2];
    const char* cA = (const char*)g.A + (size_t)cur.pm * tstepA; const char* cB = (const char*)g.Bt + (size_t)cur.pn * tstepB;
    S.a_ready(cur);
    PG8_STAGE(PG8_SB(0, 0), cB, voffB); PG8_STAGE(PG8_SA(0, 0), cA, voffA); PG8_STAGE(PG8_SB(0, 1), cB + hstepB, voffB); PG8_STAGE(PG8_SA(0, 1), cA + hstepA, voffA);
    if (wr == 1) PG8_BAR;
    PG8_WAIT_V(4); PG8_BAR;
    PG8_STAGE(PG8_SB(1, 0), cB + kstep, voffB); PG8_STAGE(PG8_SA(1, 0), cA + kstep, voffA); PG8_STAGE(PG8_SB(1, 1), cB + hstepB + kstep, voffB);
    PG8_WAIT_V(6); PG8_BAR;
    for (;;) {
        const bool has_next = S.next(ui + 1, nxt);
        const char* nA = has_next ? (const char*)g.A + (size_t)nxt.pm * tstepA : cA; const char* nB = has_next ? (const char*)g.Bt + (size_t)nxt.pn * tstepB : cB;
        for (int t = 0; t < nt; t += 2) {
            const bool last = (t == nt - 2);
            const char* a1 = cA + (size_t)(t + 1) * kstep;
            const char* a2 = last ? nA : cA + (size_t)(t + 2) * kstep; const char* b2 = last ? nB : cB + (size_t)(t + 2) * kstep;
            const char* a3 = a2 + kstep; const char* b3 = b2 + kstep;
            if (last && has_next) S.a_ready(nxt);
            PG8_LDB(B0, 0, 0); PG8_SCHED; PG8_LDA(At, 0, 0); PG8_STAGE(PG8_SA(1, 1), a1 + hstepA, voffA);
            PG8_WAIT_L(8); PG8_BAR; PG8_WAIT_L(0); PG8_MMA(0, 0, At, B0); PG8_BAR; PG8_SCHED;
            PG8_LDB(B1, 0, 1); PG8_STAGE(PG8_SB(0, 0), b2, voffB);
            PG8_BAR; PG8_WAIT_L(0); PG8_MMA(0, 1, At, B1); PG8_BAR;
            PG8_LDA(At, 0, 1); PG8_STAGE(PG8_SA(0, 0), a2, voffA);
            PG8_BAR; PG8_WAIT_L(0); PG8_MMA(1, 0, At, B0); PG8_BAR; PG8_SCHED;
            PG8_STAGE(PG8_SB(0, 1), b2 + hstepB, voffB);
            PG8_WAIT_V(6); PG8_BAR; PG8_MMA(1, 1, At, B1); PG8_BAR;
            PG8_LDB(B0, 1, 0); PG8_SCHED; PG8_LDA(At, 1, 0); PG8_STAGE(PG8_SA(0, 1), a2 + hstepA, voffA);
            PG8_WAIT_L(8); PG8_BAR; PG8_WAIT_L(0); PG8_MMA(0, 0, At, B0); PG8_BAR; PG8_SCHED;
            PG8_LDB(B1, 1, 1); PG8_STAGE(PG8_SB(1, 0), b3, voffB);
            PG8_BAR; PG8_WAIT_L(0); PG8_MMA(0, 1, At, B1); PG8_BAR;
            PG8_LDA(At, 1, 1); PG8_STAGE(PG8_SA(1, 0), a3, voffA);
            PG8_BAR; PG8_WAIT_L(0); PG8_MMA(1, 0, At, B0); PG8_BAR; PG8_SCHED;
            PG8_STAGE(PG8_SB(1, 1), b3 + hstepB, voffB);
            PG8_WAIT_V(6); PG8_BAR; PG8_MMA(1, 1, At, B1); PG8_BAR;
        }
        E(acc, cur, wr, wc, fr, fq); S.done(cur);
        if (!has_next) break;
#pragma unroll
        for (int a = 0; a < 2; ++a)
#pragma unroll
            for (int b = 0; b < 2; ++b)
#pragma unroll
                for (int m = 0; m < 4; ++m)
#pragma unroll
                    for (int n = 0; n < 2; ++n) acc[a][b][m][n] = (f32x4){0.f, 0.f, 0.f, 0.f};
        cur = nxt; cA = nA; cB = nB; ++ui;
    }
    PG8_WAIT_V(0);
    if (wr == 0) PG8_BAR;
    PG8_BAR;
#undef PG8_SA
#undef PG8_SB
#undef PG8_STAGE
#undef PG8_LDA
#undef PG8_LDB
#undef PG8_MMA
#undef PG8_WAIT_V
#undef PG8_WAIT_L
#undef PG8_BAR
#undef PG8_SCHED
}
}

struct Args { const float* in[19]; float* out; unsigned char* ws; int ph_lo, ph_hi; };
struct Frame {
    LAS unsigned char* lds; int tid, lane, wave;
    const float *x_prompt, *x_sample, *state_in, *c, *c_ctx, *w_ada, *b_ada, *norm_w, *w_in, *lower_bounds, *hgrn_norm_w, *w_pool, *pool_scale, *w_out, *w_query, *sub_keys, *expert_u, *expert_v, *final_norm_w;
    float* out; float* MOD; float* LB; bf16_t *WIN, *WOUT, *WQ, *WINU, *WPOOL, *KEYS; unsigned char *UTAB, *VTAB; float *USC, *VSC; float* X; bf16_t *HB, *P; float *OF, *OB; bf16_t *CAT, *Q; int* SELI; float* SELG; float* MODP; bf16_t* QH; float *SSEG, *DSEG;
};

DI void p0_prologue(const Frame& F) {
    LAS float* sv = (LAS float*)(F.lds);
    LAS float* red = (LAS float*)(F.lds + 24576);
    LAS float* tile = (LAS float*)(F.lds + 49152);
    const int tid = fresh_tid(F.wave), lane = tid & 63, wave = __builtin_amdgcn_readfirstlane(tid >> 6), b = blockIdx.x, G = gridDim.x;
    for (int i = tid; i < 3 * 2048; i += 512) { const int g = i >> 11, k = i & 2047; const float cv = (g == 0) ? F.c_ctx[k] : F.c[(g - 1) * 2048 + k]; sv[i] = silu_f(cv); }
    __syncthreads();
    for (int task = b; task < 768; task += G) {
        const int l = task / 192, rem = task % 192, cb = rem >> 2, kq = rem & 3;
        const float* W = F.w_ada + (size_t)l * 2048 * 12288 + cb * 256 + lane * 4;
        const int r0 = kq * 512 + wave * 64;
        f32x4 a0 = {0.f, 0.f, 0.f, 0.f}, a1 = a0, a2 = a0;
#pragma unroll 8
        for (int r = r0; r < r0 + 64; ++r) {
            const f32x4 w = __builtin_nontemporal_load((const f32x4*)(W + (size_t)r * 12288));
            a0 += sv[r] * w; a1 += sv[2048 + r] * w; a2 += sv[4096 + r] * w;
        }
        LAS float* rp = red + (wave * 3) * 256 + lane * 4;
        *(LAS f32x4*)(rp) = a0; *(LAS f32x4*)(rp + 256) = a1; *(LAS f32x4*)(rp + 512) = a2;
        __syncthreads();
        for (int i = tid; i < 768; i += 512) { const int g = i >> 8, cc = i & 255; float s = 0.f;
#pragma unroll
            for (int w = 0; w < 8; ++w) s += red[(w * 3 + g) * 256 + cc];
            const int n = cb * 256 + cc; if (kq == 0) s += F.b_ada[l * 12288 + n];
            F.MODP[(size_t)kq * MODP_STRIDE + ((size_t)(l * 3 + g)) * 12288 + n] = s; }
        __syncthreads();
    }
    if (b == G - 1) {
        for (int i = tid; i < 2048; i += 512) { const int d = i >> 10, j = i & 1023; float v[4], m = -1e30f;
#pragma unroll
            for (int l = 0; l < 4; ++l) { v[l] = F.lower_bounds[(d * 4 + l) * 1024 + j]; m = fmaxf(m, v[l]); }
            float s = 0.f;
#pragma unroll
            for (int l = 0; l < 4; ++l) { v[l] = __expf(v[l] - m); s += v[l]; }
            const float inv = 1.f / s; float cum = 0.f; const float p0 = v[0] * inv;
#pragma unroll
            for (int l = 0; l < 4; ++l) { cum += v[l] * inv; F.LB[(d * 4 + l) * 1024 + j] = cum - p0; } }
    }
    constexpr int T_WIN = 4 * 3072, T_WOUT = 4 * 1024, T_WQ = 4 * 1024, T_WPOOL = 256, T_ALL = T_WIN + T_WOUT + T_WQ + T_WPOOL;
    for (int t = b; t < T_ALL; t += G) {
        const float* src; bf16_t* dst; int lsrc, ldst; bool plain = false;
        if (t < T_WIN) { const int l = t / 3072, r = t % 3072, kt = r / 96, nt = r % 96;
            src = F.w_in + (size_t)l * 2048 * 6144 + (size_t)(kt * 64) * 6144 + nt * 64; lsrc = 6144;
            if (nt < 80) { dst = F.WIN + (size_t)l * 6144 * 2048 + (size_t)(nt * 64) * 2048 + kt * 64; ldst = 2048; }
            else { const int n = nt * 64 - 5120, g = n >> 8, cc = n & 255; dst = F.WINU + ((size_t)(l * 4 + g) * 2048 + kt * 64) * 256 + cc; ldst = 256; plain = true; } }
        else if (t < T_WIN + T_WOUT + T_WQ) { const bool isq = t >= T_WIN + T_WOUT; const int tt = t - T_WIN - (isq ? T_WOUT : 0), l = tt >> 10, kt = (tt & 1023) >> 5, nt = tt & 31;
            src = (isq ? F.w_query : F.w_out) + (size_t)l * 2048 * 2048 + (size_t)(kt * 64) * 2048 + nt * 64; lsrc = 2048;
            dst = (isq ? F.WQ : F.WOUT) + (size_t)l * 2048 * 2048 + (size_t)(nt * 64) * 2048 + kt * 64; ldst = 2048; }
        else { const int tt = t - T_WIN - T_WOUT - T_WQ, mtx = tt >> 4, ct = (tt & 15) >> 2, dt = tt & 3;
            src = F.w_pool + (size_t)mtx * 65536 + (size_t)(ct * 64) * 256 + dt * 64; lsrc = 256;
            dst = F.WPOOL + (size_t)mtx * 65536 + (size_t)(dt * 64) * 256 + ct * 64; ldst = 256; }
        const int r = tid >> 4, c4 = (tid & 15) * 4;
        const f32x4 v0 = *(const f32x4*)(src + (size_t)r * lsrc + c4), v1 = *(const f32x4*)(src + (size_t)(r + 32) * lsrc + c4);
        if (plain) {
            u32x2 o0 = {pk_bf16(v0[0], v0[1]), pk_bf16(v0[2], v0[3])}, o1 = {pk_bf16(v1[0], v1[1]), pk_bf16(v1[2], v1[3])};
            *(u32x2*)(dst + (size_t)r * ldst + c4) = o0; *(u32x2*)(dst + (size_t)(r + 32) * ldst + c4) = o1;
        } else {
#pragma unroll
            for (int j = 0; j < 4; ++j) { tile[r * 65 + c4 + j] = v0[j]; tile[(r + 32) * 65 + c4 + j] = v1[j]; }
            __syncthreads();
            const int n = tid >> 3, kk = (tid & 7) * 8; float f[8];
#pragma unroll
            for (int j = 0; j < 8; ++j) f[j] = tile[(kk + j) * 65 + n];
            u32x4 o = {pk_bf16(f[0], f[1]), pk_bf16(f[2], f[3]), pk_bf16(f[4], f[5]), pk_bf16(f[6], f[7])};
            *(u32x4*)(dst + (size_t)n * ldst + kk) = o;
            __syncthreads();
        }
    }
    const size_t k8 = (size_t)4 * 8 * 2 * 128 * 128 / 8;
    for (size_t i = (size_t)b * 512 + tid; i < k8; i += (size_t)G * 512) {
        const f32x4* s = (const f32x4*)F.sub_keys + 2 * i; const f32x4 a = s[0], cc = s[1];
        u32x4 o = {pk_bf16(a[0], a[1]), pk_bf16(a[2], a[3]), pk_bf16(cc[0], cc[1]), pk_bf16(cc[2], cc[3])}; ((u32x4*)F.KEYS)[i] = o; }
}

DI void conv_tables(const Frame& F, const int l) {
    const int tid = fresh_tid(F.wave), lane = tid & 63, wave = __builtin_amdgcn_readfirstlane(tid >> 6), b = blockIdx.x, G = gridDim.x;
    for (int row = l * 16384 + b * 8 + wave; row < (l + 1) * 16384; row += G * 8) {
#pragma unroll
        for (int tb = 0; tb < 2; ++tb) {
            const float* src = (tb ? F.expert_v : F.expert_u) + (size_t)row * D + (lane >> 5) * 1024 + (lane & 31) * 4;
            f32x4 v[8]; float m = 0.f;
#pragma unroll
            for (int k = 0; k < 8; ++k) v[k] = __builtin_nontemporal_load((const f32x4*)(src + k * 128));
#pragma unroll
            for (int k = 0; k < 8; ++k) m = fmaxf(fmaxf(m, fmaxf(fabsf(v[k][0]), fabsf(v[k][1]))), fmaxf(fabsf(v[k][2]), fabsf(v[k][3])));
            float sc = m > 0.f ? m * (tb == 0 ? (1.0f / 7.0f) : (1.0f / 6.0f)) : 1.0f;
            const unsigned scb = (__float_as_uint(sc) + 0xffffu) >> 16; sc = __uint_as_float(scb << 16);
            const float inv = 1.0f / sc;
            unsigned pw[4];
            if (tb == 0) {
#pragma unroll
                for (int dd = 0; dd < 4; ++dd) { unsigned p = 0u;
#pragma unroll
                    for (int n = 0; n < 8; ++n) { const float xq = ((n < 4) ? v[2 * dd][n & 3] : v[2 * dd + 1][n & 3]) * inv; int q = (int)rintf(xq); q = q < -8 ? -8 : (q > 7 ? 7 : q); p |= (unsigned)(q & 15) << (4 * n); }
                    pw[dd] = p; }
            } else {
#pragma unroll
            for (int dd = 0; dd < 4; ++dd) { unsigned p = 0u;
                p = __builtin_amdgcn_cvt_scalef32_pk_fp4_f32(p, v[2 * dd][0] * inv, v[2 * dd][1] * inv, 1.0f, 0);
                p = __builtin_amdgcn_cvt_scalef32_pk_fp4_f32(p, v[2 * dd][2] * inv, v[2 * dd][3] * inv, 1.0f, 1);
                p = __builtin_amdgcn_cvt_scalef32_pk_fp4_f32(p, v[2 * dd + 1][0] * inv, v[2 * dd + 1][1] * inv, 1.0f, 2);
                p = __builtin_amdgcn_cvt_scalef32_pk_fp4_f32(p, v[2 * dd + 1][2] * inv, v[2 * dd + 1][3] * inv, 1.0f, 3);
                pw[dd] = p; }
            }
            unsigned char* dst = (tb ? F.VTAB : F.UTAB) + (size_t)row * ROWB;
            *(u32x4*)(dst + (lane & 31) * 32 + (lane >> 5) * 16) = (u32x4){pw[0], pw[1], pw[2], pw[3]};
            *(unsigned short*)(dst + 1024 + (lane & 31) * 4 + (lane >> 5) * 2) = (unsigned short)scb;
        }
    }
}

template <int NPART> DI void norm_rows(const Frame& F, const float* xp, const float* xs, const float* nw, const float* modl, int sh_off, int sc_off) {
    const int tid = fresh_tid(F.wave), lane = tid & 63, wave = __builtin_amdgcn_readfirstlane(tid >> 6);
    for (int row = blockIdx.x * 8 + wave; row < NTOK; row += gridDim.x * 8) {
        const float* x = (row < TP) ? xp + (size_t)row * D : xs + (size_t)(row - TP) * D;
        const int grp = (row < TP) ? 0 : 1 + ((row - TP) >> 11);
        const float* md = modl + (size_t)grp * 12288;
        f32x4 v[8]; float ss = 0.f;
#pragma unroll
        for (int j = 0; j < 8; ++j) { v[j] = *(const f32x4*)(x + j * 256 + lane * 4); ss += v[j][0] * v[j][0] + v[j][1] * v[j][1] + v[j][2] * v[j][2] + v[j][3] * v[j][3]; }
        ss = wave_sum(ss);
        const float rstd = __frsqrt_rn(ss * (1.0f / 2048.0f) + EPS);
#pragma unroll
        for (int j = 0; j < 8; ++j) { const int cidx = j * 256 + lane * 4;
            const f32x4 w = *(const f32x4*)(nw + cidx); f32x4 sc = *(const f32x4*)(md + sc_off + cidx), sh = *(const f32x4*)(md + sh_off + cidx);
#pragma unroll
            for (int p = 1; p < NPART; ++p) { sc += *(const f32x4*)(md + p * MODP_STRIDE + sc_off + cidx); sh += *(const f32x4*)(md + p * MODP_STRIDE + sh_off + cidx); }
            const f32x4 h = v[j] * rstd * w * (1.0f + sc) + sh;
            u32x2 o = {pk_bf16(h[0], h[1]), pk_bf16(h[2], h[3])};
            *(u32x2*)(F.HB + (size_t)row * D + cidx) = o; }
    }
}

constexpr int SC_QT = 0, SC_KH = 8704, SC_KT = 17408, SC_VT = 27648, SC_EB = 37888, SC_BUF = 38400;
DI bf16x8 pack8(const f32x16& x, const int s) {
    u32x4 p = {pk_bf16(x[8 * s], x[8 * s + 1]), pk_bf16(x[8 * s + 2], x[8 * s + 3]), pk_bf16(x[8 * s + 4], x[8 * s + 5]), pk_bf16(x[8 * s + 6], x[8 * s + 7])};
    return __builtin_bit_cast(bf16x8, p);
}
DI bf16x8 lds_2x8(const LAS unsigned char* p) {
    const u32x2 a = *(const LAS u32x2*)p, b = *(const LAS u32x2*)(p + 16);
    u32x4 r = {a[0], a[1], b[0], b[1]}; return __builtin_bit_cast(bf16x8, r);
}
DI void p3_scan(const Frame& F, const int l) {
    const int b = blockIdx.x; if (b >= 256) return;
    int tok0, T, bseq, h, cbeg; bool sample;
    if (b < 128) { sample = false; bseq = b >> 3; h = b & 7; T = 256; tok0 = bseq * 256; cbeg = 0; }
    else { sample = true; const int ix = b - 128; bseq = ix >> 6; cbeg = ((ix >> 3) & 7) * 8; h = ix & 7; T = 2048; tok0 = TP + bseq * 2048; }
    const int tid = fresh_tid(F.wave), lane = tid & 63, wave = __builtin_amdgcn_readfirstlane(tid >> 6);
    const int dir = wave >> 2, wv = wave & 3, r = lane & 31, hh = lane >> 5;
    LAS unsigned char* gbase = F.lds + dir * (2 * SC_BUF);
    const int cp = lane & 15, tg = lane >> 4, ch0 = 32 * wv + 2 * cp;
    const float lb0 = F.LB[(dir * 4 + l) * 1024 + h * 128 + ch0], lb1 = F.LB[(dir * 4 + l) * 1024 + h * 128 + ch0 + 1];
    const float om0 = 1.f - lb0, om1 = 1.f - lb1;
    const bf16_t* pcol = F.P + h * 128 + ch0;
    const int zoff = 1024 * (1 + dir);
    float* obuf = (dir ? F.OB : F.OF) + h * 128 + 32 * wv + r;
    f32x16 S[4];
#pragma unroll
    for (int mb = 0; mb < 4; ++mb)
#pragma unroll
        for (int i = 0; i < 16; ++i) S[mb][i] = 0.f;
    float bprev0 = 0.f, bprev1 = 0.f;
    unsigned qq[8], zz[8], vv[8], qn[8], zn[8], vn[8];
#pragma unroll
    for (int j = 0; j < 8; ++j) { int pos = cbeg * 32 + 8 * tg + j; if (dir) pos = T - 1 - pos; const bf16_t* rowp = pcol + (size_t)(tok0 + pos) * DIN;
        qq[j] = *(const unsigned*)rowp; zz[j] = *(const unsigned*)(rowp + zoff); vv[j] = *(const unsigned*)(rowp + 3072); }
#pragma unroll
    for (int j = 0; j < 8; ++j) { int pos = (cbeg + 1) * 32 + 8 * tg + j; if (dir) pos = T - 1 - pos; const bf16_t* rowp = pcol + (size_t)(tok0 + pos) * DIN;
        qn[j] = *(const unsigned*)rowp; zn[j] = *(const unsigned*)(rowp + zoff); vn[j] = *(const unsigned*)(rowp + 3072); }
    const float scale = 0.08838834764831845f;
    for (int c = cbeg; c < cbeg + 8; ++c) {
        LAS unsigned char* buf = gbase + (c & 1) * SC_BUF;
        {
            float bc0[8], bc1[8], k0[8], k1[8]; float run0 = 0.f, run1 = 0.f;
#pragma unroll
            for (int j = 0; j < 8; ++j) {
                const float z0 = fmaxf(bf_lo(zz[j]), -80.f), z1 = fmaxf(bf_hi(zz[j]), -80.f);
                const float e0 = __expf(-z0), e1 = __expf(-z1);
                const float s0 = __builtin_amdgcn_rcpf(1.f + e0), s1 = __builtin_amdgcn_rcpf(1.f + e1);
                const float f0 = lb0 + om0 * s0, f1 = lb1 + om1 * s1;
                k0[j] = om0 * e0 * s0; k1[j] = om1 * e1 * s1;
                run0 += __logf(f0); run1 += __logf(f1); bc0[j] = run0; bc1[j] = run1;
            }
#define LANE_GET(v, ln) __int_as_float(__builtin_amdgcn_ds_bpermute((ln) << 2, __float_as_int(v)))
            const float a00 = LANE_GET(run0, cp), a01 = LANE_GET(run0, cp + 16), a02 = LANE_GET(run0, cp + 32), a03 = LANE_GET(run0, cp + 48);
            const float a10 = LANE_GET(run1, cp), a11 = LANE_GET(run1, cp + 16), a12 = LANE_GET(run1, cp + 32), a13 = LANE_GET(run1, cp + 48);
#undef LANE_GET
            const float off0 = (tg > 0 ? a00 : 0.f) + (tg > 1 ? a01 : 0.f) + (tg > 2 ? a02 : 0.f);
            const float off1 = (tg > 0 ? a10 : 0.f) + (tg > 1 ? a11 : 0.f) + (tg > 2 ? a12 : 0.f);
            unsigned kt0[4], kt1[4], vt0[4], vt1[4]; float kh0[8], kh1[8];
            const float ep0 = __expf(bprev0), ep1 = __expf(bprev1);
#pragma unroll
            for (int j = 0; j < 8; ++j) {
                const float B0 = off0 + bc0[j], B1 = off1 + bc1[j];
                const float eq0 = __expf(B0), eq1 = __expf(B1), ek0 = __expf(fminf(-B0, 85.f)), ek1 = __expf(fminf(-B1, 85.f));
                const float qt0 = bf_lo(qq[j]) * eq0, qt1 = bf_hi(qq[j]) * eq1;
                kh0[j] = k0[j] * ek0; kh1[j] = k1[j] * ek1;
                const int rr = 8 * tg + j;
                *(LAS unsigned*)(buf + SC_QT + rr * 272 + ch0 * 2) = pk_bf16(qt0, qt1);
                *(LAS unsigned*)(buf + SC_KH + rr * 272 + ch0 * 2) = pk_bf16(kh0[j], kh1[j]);
                if (sample) { int pos = c * 32 + rr; if (dir) pos = T - 1 - pos;
                    *(unsigned*)(F.QH + ((size_t)dir * 4096 + bseq * 2048 + pos) * 1024 + h * 128 + ch0) = pk_bf16(qt0 * ep0, qt1 * ep1); }
            }
#pragma unroll
            for (int j = 0; j < 4; ++j) { kt0[j] = pk_bf16(kh0[2 * j], kh0[2 * j + 1]); kt1[j] = pk_bf16(kh1[2 * j], kh1[2 * j + 1]);
                vt0[j] = (vv[2 * j] & 0xffffu) | (vv[2 * j + 1] << 16); vt1[j] = (vv[2 * j] >> 16) | (vv[2 * j + 1] & 0xffff0000u); }
            *(LAS u32x4*)(buf + SC_KT + ch0 * 80 + 16 * tg) = (u32x4){kt0[0], kt0[1], kt0[2], kt0[3]};
            *(LAS u32x4*)(buf + SC_KT + (ch0 + 1) * 80 + 16 * tg) = (u32x4){kt1[0], kt1[1], kt1[2], kt1[3]};
            *(LAS u32x4*)(buf + SC_VT + ch0 * 80 + 16 * tg) = (u32x4){vt0[0], vt0[1], vt0[2], vt0[3]};
            *(LAS u32x4*)(buf + SC_VT + (ch0 + 1) * 80 + 16 * tg) = (u32x4){vt1[0], vt1[1], vt1[2], vt1[3]};
            const float t0 = a00 + a01 + a02 + a03, t1 = a10 + a11 + a12 + a13; bprev0 += t0; bprev1 += t1;
            if (tg == 0) *(LAS f32x2*)(buf + SC_EB + ch0 * 4) = (f32x2){__expf(t0), __expf(t1)};
        }
#pragma unroll
        for (int j = 0; j < 8; ++j) { qq[j] = qn[j]; zz[j] = zn[j]; vv[j] = vn[j]; }
        if (c + 2 < cbeg + 8) {
#pragma unroll
            for (int j = 0; j < 8; ++j) { int pos = (c + 2) * 32 + 8 * tg + j; if (dir) pos = T - 1 - pos; const bf16_t* rowp = pcol + (size_t)(tok0 + pos) * DIN;
                qn[j] = *(const unsigned*)rowp; zn[j] = *(const unsigned*)(rowp + zoff); vn[j] = *(const unsigned*)(rowp + 3072); }
        }
        __syncthreads();
        f32x16 Pm;
#pragma unroll
        for (int i = 0; i < 16; ++i) Pm[i] = 0.f;
#pragma unroll
        for (int ks = 0; ks < 8; ++ks) {
            const bf16x8 a = *(const LAS bf16x8*)(buf + SC_KH + r * 272 + (16 * ks + 8 * hh) * 2);
            const bf16x8 bq = *(const LAS bf16x8*)(buf + SC_QT + r * 272 + (16 * ks + 8 * hh) * 2);
            Pm = MFMA32(a, bq, Pm);
        }
#pragma unroll
        for (int i = 0; i < 16; ++i) Pm[i] = (crow(i, hh) <= r) ? Pm[i] : 0.f;
        f32x16 O;
#pragma unroll
        for (int i = 0; i < 16; ++i) O[i] = 0.f;
#pragma unroll
        for (int mb = 0; mb < 4; ++mb)
#pragma unroll
            for (int s2 = 0; s2 < 2; ++s2) {
                const bf16x8 a = lds_2x8(buf + SC_QT + r * 272 + (32 * mb + 16 * s2 + 4 * hh) * 2);
                O = MFMA32(a, pack8(S[mb], s2), O);
            }
#pragma unroll
        for (int s2 = 0; s2 < 2; ++s2) {
            const bf16x8 bv = lds_2x8(buf + SC_VT + (32 * wv + r) * 80 + (16 * s2 + 4 * hh) * 2);
            O = MFMA32(pack8(Pm, s2), bv, O);
        }
#pragma unroll
        for (int mb = 0; mb < 4; ++mb) {
#pragma unroll
            for (int ks = 0; ks < 2; ++ks) {
                const bf16x8 a = *(const LAS bf16x8*)(buf + SC_KT + (32 * mb + r) * 80 + (16 * ks + 8 * hh) * 2);
                const bf16x8 bv = *(const LAS bf16x8*)(buf + SC_VT + (32 * wv + r) * 80 + (16 * ks + 8 * hh) * 2);
                S[mb] = MFMA32(a, bv, S[mb]);
            }
#pragma unroll
            for (int q4 = 0; q4 < 4; ++q4) { const f32x4 e = *(const LAS f32x4*)(buf + SC_EB + (32 * mb + 8 * q4 + 4 * hh) * 4);
#pragma unroll
                for (int j = 0; j < 4; ++j) S[mb][4 * q4 + j] *= e[j]; }
        }
#pragma unroll
        for (int i = 0; i < 16; ++i) { int pos = c * 32 + crow(i, hh); if (dir) pos = T - 1 - pos; obuf[(size_t)(tok0 + pos) * 1024] = O[i] * scale; }
    }
    float* so;
    if (!sample) so = F.out + (size_t)NTOK * D + ((size_t)((bseq * 4 + l) * 2 + dir) * 8 + h) * 16384 + 32 * wv + r;
    else { const int u = ((bseq * 2 + dir) * 8 + h) * 8 + (cbeg >> 3); so = F.SSEG + (size_t)u * 16384 + 32 * wv + r;
        if (tg == 0) *(f32x2*)(F.DSEG + (size_t)u * 128 + ch0) = (f32x2){__expf(bprev0), __expf(bprev1)}; }
#pragma unroll
    for (int mb = 0; mb < 4; ++mb)
#pragma unroll
        for (int i = 0; i < 16; ++i) so[(32 * mb + crow(i, hh)) * 128] = S[mb][i];
}

DI void p3c_correct(const Frame& F, const int l) {
    const int u = blockIdx.x; if (u >= 256) return;
    const int tid = fresh_tid(F.wave), lane = tid & 63, wave = __builtin_amdgcn_readfirstlane(tid >> 6), r = lane & 31, hh = lane >> 5;
    const int sseq = u >> 7, dir = (u >> 6) & 1, h = (u >> 3) & 7, seg = u & 7, ub = u - seg;
    {
        const int v = tid & 127, kq = tid >> 7;
        const float* st0 = F.state_in + ((size_t)((sseq * 4 + l) * 2 + dir) * 8 + h) * 16384 + v;
        float val[32];
#pragma unroll
        for (int kk = 0; kk < 32; ++kk) val[kk] = st0[(kq * 32 + kk) * 128];
        for (int j = 0; j < seg; ++j) { const float* sp = F.SSEG + (size_t)(ub + j) * 16384 + v; const float* dp = F.DSEG + (size_t)(ub + j) * 128;
#pragma unroll
            for (int kk = 0; kk < 32; ++kk) val[kk] = dp[kq * 32 + kk] * val[kk] + sp[(kq * 32 + kk) * 128]; }
#pragma unroll
        for (int g = 0; g < 4; ++g)
            *(LAS u32x4*)(F.lds + v * 272 + (kq * 32 + 8 * g) * 2) = (u32x4){pk_bf16(val[8 * g], val[8 * g + 1]), pk_bf16(val[8 * g + 2], val[8 * g + 3]), pk_bf16(val[8 * g + 4], val[8 * g + 5]), pk_bf16(val[8 * g + 6], val[8 * g + 7])};
    }
    __syncthreads();
    int posr = seg * 256 + 32 * wave + r; if (dir) posr = 2047 - posr;
    const bf16_t* qp = F.QH + ((size_t)dir * 4096 + sseq * 2048 + posr) * 1024 + h * 128 + 8 * hh;
    bf16x8 a[8];
#pragma unroll
    for (int ks = 0; ks < 8; ++ks) a[ks] = *(const bf16x8*)(qp + 16 * ks);
    float* ob = (dir ? F.OB : F.OF) + (size_t)(TP + sseq * 2048) * 1024 + h * 128 + r;
    const float scale = 0.08838834764831845f;
#pragma unroll
    for (int nb = 0; nb < 4; ++nb) {
        f32x16 acc;
#pragma unroll
        for (int i = 0; i < 16; ++i) acc[i] = 0.f;
#pragma unroll
        for (int ks = 0; ks < 8; ++ks) { const bf16x8 bv = *(const LAS bf16x8*)(F.lds + (32 * nb + r) * 272 + (16 * ks + 8 * hh) * 2); acc = MFMA32(a[ks], bv, acc); }
#pragma unroll
        for (int i = 0; i < 16; ++i) { int pos = seg * 256 + 32 * wave + crow(i, hh); if (dir) pos = 2047 - pos; float* op = ob + (size_t)pos * 1024 + 32 * nb; *op += scale * acc[i]; }
    }
}

DI void p4_combine(const Frame& F, const int l) {
    const int tid = fresh_tid(F.wave), lane = tid & 63, wave = __builtin_amdgcn_readfirstlane(tid >> 6), c0 = lane * 16;
    for (int tok = blockIdx.x * 8 + wave; tok < NTOK; tok += gridDim.x * 8) {
        {
            const float* pf = F.OF + (size_t)tok * 1024 + c0; const float* pb = F.OB + (size_t)tok * 1024 + c0;
            f32x4 o[4]; float ss = 0.f;
#pragma unroll
            for (int j = 0; j < 4; ++j) { o[j] = *(const f32x4*)(pf + 4 * j) + *(const f32x4*)(pb + 4 * j); ss += o[j][0] * o[j][0] + o[j][1] * o[j][1] + o[j][2] * o[j][2] + o[j][3] * o[j][3]; }
            ss += xshfl<1>(ss); ss += xshfl<2>(ss); ss += xshfl<4>(ss);
            const float rstd = __frsqrt_rn(ss * (1.0f / 128.0f) + EPS);
            const u32x4 g0 = *(const u32x4*)(F.P + (size_t)tok * DIN + 4096 + c0), g1 = *(const u32x4*)(F.P + (size_t)tok * DIN + 4096 + c0 + 8);
            const float* gw = F.hgrn_norm_w + l * 1024 + c0;
            unsigned w[8];
#pragma unroll
            for (int j = 0; j < 4; ++j) { const f32x4 gn = *(const f32x4*)(gw + 4 * j); const unsigned ga = (j < 2) ? g0[2 * j] : g1[2 * j - 4], gb = (j < 2) ? g0[2 * j + 1] : g1[2 * j - 3];
                const float r0 = o[j][0] * rstd * gn[0] * silu_f(bf_lo(ga)), r1 = o[j][1] * rstd * gn[1] * silu_f(bf_hi(ga));
                const float r2 = o[j][2] * rstd * gn[2] * silu_f(bf_lo(gb)), r3 = o[j][3] * rstd * gn[3] * silu_f(bf_hi(gb));
                w[2 * j] = pk_bf16(r0, r1); w[2 * j + 1] = pk_bf16(r2, r3); }
            bf16_t* dst = F.CAT + (size_t)tok * D + c0;
            *(u32x4*)dst = (u32x4){w[0], w[1], w[2], w[3]}; *(u32x4*)(dst + 8) = (u32x4){w[4], w[5], w[6], w[7]};
        }
        {
            const int gi = lane >> 4, half = 1 << gi;
            int L, pos; if (tok < TP) { L = 256; pos = tok & 255; } else { L = 64; pos = (tok - TP) & 63; }
            const int sbase = tok - pos; int lo = pos - half; lo = lo < 0 ? 0 : lo; int hi = pos + half; hi = hi > L ? L : hi;
            float acc[16];
#pragma unroll
            for (int j = 0; j < 16; ++j) acc[j] = 0.f;
            const bf16_t* pu = F.P + 5120 + c0;
            for (int d0 = -half; d0 < half; d0 += 4) {
                u32x4 a[4], bq[4]; float mk[4];
#pragma unroll
                for (int u = 0; u < 4; ++u) { const int d = d0 + u, t = pos + d; const bool ok = (d < half) && (t >= 0) && (t < L); const int tt = ok ? t : pos; mk[u] = ok ? 1.f : 0.f;
                    a[u] = *(const u32x4*)(pu + (size_t)(sbase + tt) * DIN); bq[u] = *(const u32x4*)(pu + (size_t)(sbase + tt) * DIN + 8); }
#pragma unroll
                for (int u = 0; u < 4; ++u)
#pragma unroll
                    for (int j = 0; j < 4; ++j) { acc[2 * j] += mk[u] * bf_lo(a[u][j]); acc[2 * j + 1] += mk[u] * bf_hi(a[u][j]); acc[8 + 2 * j] += mk[u] * bf_lo(bq[u][j]); acc[9 + 2 * j] += mk[u] * bf_hi(bq[u][j]); } }
            const float inv = 1.0f / (float)(hi - lo);
            const u32x4 sa = *(const u32x4*)(pu + (size_t)tok * DIN), sb = *(const u32x4*)(pu + (size_t)tok * DIN + 8);
            const float* ps = F.pool_scale + l * 1024 + c0;
            unsigned w[8];
#pragma unroll
            for (int j = 0; j < 4; ++j) { const f32x4 s0 = *(const f32x4*)(ps + 4 * j);
                const unsigned ua = (j < 2) ? sa[2 * j] : sb[2 * j - 4], ub = (j < 2) ? sa[2 * j + 1] : sb[2 * j - 3];
                const float r0 = (acc[4 * j] * inv - bf_lo(ua)) * s0[0], r1 = (acc[4 * j + 1] * inv - bf_hi(ua)) * s0[1];
                const float r2 = (acc[4 * j + 2] * inv - bf_lo(ub)) * s0[2], r3 = (acc[4 * j + 3] * inv - bf_hi(ub)) * s0[3];
                w[2 * j] = pk_bf16(r0, r1); w[2 * j + 1] = pk_bf16(r2, r3); }
            bf16_t* dst = F.CAT + (size_t)tok * D + 1024 + c0;
            *(u32x4*)dst = (u32x4){w[0], w[1], w[2], w[3]}; *(u32x4*)(dst + 8) = (u32x4){w[4], w[5], w[6], w[7]};
        }
    }
}

#define CE_D(a, b) do { const float _h = fmaxf(a, b), _l = fminf(a, b); a = _h; b = _l; } while (0)
#define CE_A(a, b) do { const float _h = fmaxf(a, b), _l = fminf(a, b); a = _l; b = _h; } while (0)
template <int N> DI void bitonic_sort_desc(float* v) {
#pragma unroll
    for (int k = 2; k <= N; k <<= 1)
#pragma unroll
        for (int j = k >> 1; j > 0; j >>= 1)
#pragma unroll
            for (int i = 0; i < N; ++i) { const int x = i ^ j; if (x > i) { if ((i & k) == 0) CE_D(v[i], v[x]); else CE_A(v[i], v[x]); } }
}
template <int N> DI void bitonic_merge_desc(float* v) {
#pragma unroll
    for (int j = N >> 1; j > 0; j >>= 1)
#pragma unroll
        for (int i = 0; i < N; ++i) { const int x = i ^ j; if (x > i) CE_D(v[i], v[x]); }
}
#define CEP_D(ka, kb, pa, pb) do { const bool _s = (kb) > (ka); const float _k = _s ? (kb) : (ka); kb = _s ? (ka) : (kb); ka = _k; const unsigned _p = _s ? (pb) : (pa); pb = _s ? (pa) : (pb); pa = _p; } while (0)
#define CEP_A(ka, kb, pa, pb) do { const bool _s = (kb) < (ka); const float _k = _s ? (kb) : (ka); kb = _s ? (ka) : (kb); ka = _k; const unsigned _p = _s ? (pb) : (pa); pb = _s ? (pa) : (pb); pa = _p; } while (0)
template <int N> DI void bitonic_sort_desc_p(float* v, unsigned* p) {
#pragma unroll
    for (int k = 2; k <= N; k <<= 1)
#pragma unroll
        for (int j = k >> 1; j > 0; j >>= 1)
#pragma unroll
            for (int i = 0; i < N; ++i) { const int x = i ^ j; if (x > i) { if ((i & k) == 0) CEP_D(v[i], v[x], p[i], p[x]); else CEP_A(v[i], v[x], p[i], p[x]); } }
}
template <int N> DI void bitonic_merge_desc_p(float* v, unsigned* p) {
#pragma unroll
    for (int j = N >> 1; j > 0; j >>= 1)
#pragma unroll
        for (int i = 0; i < N; ++i) { const int x = i ^ j; if (x > i) CEP_D(v[i], v[x], p[i], p[x]); }
}
DI void p8_topk(const Frame& F, const int l, const pg8::StaticOrder& S) {
    const int tid = fresh_tid(F.wave), lane = tid & 63, wave = __builtin_amdgcn_readfirstlane(tid >> 6), r = lane & 31, hh = lane >> 5;
    pg8::Unit u;
    for (int ui = 0; S.next(ui, u); ++ui) {
        const int tile = u.pm * 8 + wave, h = u.pn; const int tok = tile * 32 + r;
        float s1[16], s2[16];
#pragma unroll 1
        for (int p = 0; p < 2; ++p) {
            const bf16_t* qrow = F.Q + (size_t)tok * D + h * 256 + p * 128 + 8 * hh;
            bf16x8 bq[8];
#pragma unroll
            for (int ks = 0; ks < 8; ++ks) bq[ks] = *(const bf16x8*)(qrow + 16 * ks);
            const bf16_t* kb = F.KEYS + ((size_t)((l * 8 + h) * 2 + p) * 128) * 128 + 8 * hh;
            float best[16];
#pragma unroll
            for (int i = 0; i < 16; ++i) best[i] = -INFINITY;
#pragma unroll 1
            for (int mb = 0; mb < 4; ++mb) {
                f32x16 acc;
#pragma unroll
                for (int i = 0; i < 16; ++i) acc[i] = 0.f;
#pragma unroll
                for (int ks = 0; ks < 8; ++ks) { const bf16x8 a = *(const bf16x8*)(kb + (size_t)(32 * mb + r) * 128 + 16 * ks); acc = MFMA32(a, bq[ks], acc); }
                float sc[16];
#pragma unroll
                for (int i = 0; i < 16; ++i) sc[i] = __uint_as_float((__float_as_uint(acc[i]) & ~127u) | (unsigned)(32 * mb + crow(i, hh)));
                bitonic_sort_desc<16>(sc);
#pragma unroll
                for (int i = 0; i < 16; ++i) best[i] = fmaxf(best[i], sc[15 - i]);
                bitonic_merge_desc<16>(best);
            }
            float pbv[16];
#pragma unroll
            for (int i = 0; i < 16; ++i) pbv[i] = xshfl<32>(best[i]);
#pragma unroll
            for (int i = 0; i < 16; ++i) best[i] = fmaxf(best[i], pbv[15 - i]);
            bitonic_merge_desc<16>(best);
            if (p == 0) {
#pragma unroll
                for (int i = 0; i < 16; ++i) s1[i] = best[i];
            } else {
#pragma unroll
                for (int i = 0; i < 16; ++i) s2[i] = best[i];
            }
        }
        float ca[16], cb[16]; unsigned ia[16], ib[16];
        const unsigned sha = hh ? 0u : 7u, shb = hh ? 7u : 0u;
#pragma unroll
        for (int i = 0; i < 16; ++i) { ca[i] = hh ? s2[i] : s1[i]; cb[i] = hh ? s1[i] : s2[i];
            ia[i] = (__float_as_uint(ca[i]) & 127u) << sha; ib[i] = (__float_as_uint(cb[i]) & 127u) << shb; }
        float cs[32]; unsigned cid[32];
        {
            int n = 0;
#pragma unroll
            for (int i = 0; i < 4; ++i)
#pragma unroll
                for (int j = i; j < 16; ++j) if ((i + 1) * (j + 1) <= 16) { float sv = ca[i] + cb[j]; if (i == j && hh) sv = -INFINITY; cs[n] = sv; cid[n] = ia[i] | ib[j]; ++n; }
#pragma unroll
            for (; n < 32; ++n) { cs[n] = -INFINITY; cid[n] = 0u; }
        }
        float tk[16]; unsigned ti[16];
#pragma unroll
        for (int i = 0; i < 16; ++i) { tk[i] = -INFINITY; ti[i] = 0u; }
#pragma unroll 1
        for (int it = 0; it < 2; ++it) {
            float ck[16]; unsigned ci[16];
#pragma unroll
            for (int i = 0; i < 16; ++i) { ck[i] = it ? cs[16 + i] : cs[i]; ci[i] = it ? cid[16 + i] : cid[i]; }
            bitonic_sort_desc_p<16>(ck, ci);
#pragma unroll
            for (int i = 0; i < 16; ++i) { const bool sw = ck[15 - i] > tk[i]; tk[i] = sw ? ck[15 - i] : tk[i]; ti[i] = sw ? ci[15 - i] : ti[i]; }
            bitonic_merge_desc_p<16>(tk, ti);
        }
        float pk_[16]; unsigned pi_[16];
#pragma unroll
        for (int i = 0; i < 16; ++i) { pk_[i] = xshfl<32>(tk[i]); pi_[i] = __float_as_uint(xshfl<32>(__uint_as_float(ti[i]))); }
        float fk[16]; unsigned fi[16]; float mx = -INFINITY;
#pragma unroll
        for (int i = 0; i < 16; ++i) { const bool sw = pk_[15 - i] > tk[i]; fk[i] = sw ? pk_[15 - i] : tk[i]; fi[i] = sw ? pi_[15 - i] : ti[i]; mx = fmaxf(mx, fk[i]); }
        float z = 0.f;
#pragma unroll
        for (int i = 0; i < 16; ++i) { fk[i] = __expf(fk[i] - mx); z += fk[i]; }
        const float iz = 1.0f / z;
        int* di = F.SELI + (size_t)tok * 128 + h * 16 + hh * 8; float* dg = F.SELG + (size_t)tok * 128 + h * 16 + hh * 8;
        *(u32x4*)di = (u32x4){fi[0], fi[1], fi[2], fi[3]}; *(u32x4*)(di + 4) = (u32x4){fi[4], fi[5], fi[6], fi[7]};
        *(f32x4*)dg = (f32x4){fk[0] * iz, fk[1] * iz, fk[2] * iz, fk[3] * iz}; *(f32x4*)(dg + 4) = (f32x4){fk[4] * iz, fk[5] * iz, fk[6] * iz, fk[7] * iz};
    }
}

constexpr int NB = 4;
DI float reduce8(const float (&p)[8], const int lane) {
    const bool b5 = lane & 32, b4 = lane & 16, b3 = lane & 8;
    float k4[4], k2[2];
#pragma unroll
    for (int i = 0; i < 4; ++i) { const float snd = b5 ? p[i] : p[i + 4], kp = b5 ? p[i + 4] : p[i]; k4[i] = kp + xshfl<32>(snd); }
#pragma unroll
    for (int i = 0; i < 2; ++i) { const float snd = b4 ? k4[i] : k4[i + 2], kp = b4 ? k4[i + 2] : k4[i]; k2[i] = kp + xshfl<16>(snd); }
    const float snd = b3 ? k2[0] : k2[1], kp = b3 ? k2[1] : k2[0];
    float t = kp + xshfl<8>(snd);
    t += xshfl<4>(t); t += xshfl<2>(t); t += xshfl<1>(t);
    return t;
}
#define CVT8(x, hi) __builtin_amdgcn_cvt_pk_f32_fp8((x), (hi))
constexpr int NT = 2;
DI float half_sum(float v) { v += xshfl<16>(v); v += xshfl<8>(v); v += xshfl<4>(v); v += xshfl<2>(v); v += xshfl<1>(v); return v; }
DI float half_max(float v) { v = fmaxf(v, xshfl<16>(v)); v = fmaxf(v, xshfl<8>(v)); v = fmaxf(v, xshfl<4>(v)); v = fmaxf(v, xshfl<2>(v)); v = fmaxf(v, xshfl<1>(v)); return v; }
DI float reduce8h(const float (&p)[8], const int lane) {
    const bool b4 = lane & 16, b3 = lane & 8, b2 = lane & 4;
    float k4[4], k2[2];
#pragma unroll
    for (int i = 0; i < 4; ++i) { const float snd = b4 ? p[i] : p[i + 4], kp = b4 ? p[i + 4] : p[i]; k4[i] = kp + xshfl<16>(snd); }
#pragma unroll
    for (int i = 0; i < 2; ++i) { const float snd = b3 ? k4[i] : k4[i + 2], kp = b3 ? k4[i + 2] : k4[i]; k2[i] = kp + xshfl<8>(snd); }
    const float snd = b2 ? k2[0] : k2[1], kp = b2 ? k2[1] : k2[0];
    float t = kp + xshfl<4>(snd);
    t += xshfl<2>(t); t += xshfl<1>(t);
    return t;
}
struct RowH { u32x4 d[2]; unsigned s; };
DI h32v blk_decode(const RowH& r, const int t) { h32v e;
#pragma unroll
    for (int dd = 0; dd < 4; ++dd)
        { const unsigned w = r.d[t][dd];
          const h2v v0 = __builtin_amdgcn_cvt_scalef32_pk_f16_fp4(w, 1.0f, 0), v1 = __builtin_amdgcn_cvt_scalef32_pk_f16_fp4(w, 1.0f, 1), v2 = __builtin_amdgcn_cvt_scalef32_pk_f16_fp4(w, 1.0f, 2), v3 = __builtin_amdgcn_cvt_scalef32_pk_f16_fp4(w, 1.0f, 3);
          e[8 * dd] = v0.x; e[8 * dd + 1] = v0.y; e[8 * dd + 2] = v1.x; e[8 * dd + 3] = v1.y; e[8 * dd + 4] = v2.x; e[8 * dd + 5] = v2.y; e[8 * dd + 6] = v3.x; e[8 * dd + 7] = v3.y; }
    return e; }
DI float blk_scale(const RowH& r, const int t) { return t ? __uint_as_float(r.s & 0xffff0000u) : __uint_as_float(r.s << 16); }
DI float dot64(const RowH& r, const h2v (&hv)[32]) {
    float tot = 0.f;
#pragma unroll
    for (int t = 0; t < 2; ++t) { const h32v e = blk_decode(r, t); float acc = 0.f;
#pragma unroll
        for (int p = 0; p < 16; ++p) acc = __builtin_amdgcn_fdot2((h2v){e[2 * p], e[2 * p + 1]}, hv[t * 16 + p], acc, false);
        tot += acc * blk_scale(r, t); }
    return tot;
}
DI float dot64i(const RowH& r, const int (&hh)[8], const int (&hl)[8], const float (&shs)[2]) {
    float tot = 0.f;
#pragma unroll
    for (int t = 0; t < 2; ++t) { int ah = 0, al = 0;
#pragma unroll
        for (int dd = 0; dd < 4; ++dd) { ah = __builtin_amdgcn_sdot8((int)r.d[t][dd], hh[t * 4 + dd], ah, false); al = __builtin_amdgcn_sdot8((int)r.d[t][dd], hl[t * 4 + dd], al, false); }
        tot += (float)(ah * 16 + al) * (blk_scale(r, t) * shs[t]); }
    return tot;
}
DI void axpy64(const RowH& r, h2v (&ov)[32], const float w) {
#pragma unroll
    for (int t = 0; t < 2; ++t) { const h32v e = blk_decode(r, t); const _Float16 ws = (_Float16)(w * blk_scale(r, t)); const h2v wv = {ws, ws};
#pragma unroll
        for (int p = 0; p < 16; ++p) ov[t * 16 + p] += (h2v){e[2 * p], e[2 * p + 1]} * wv; }
}
DI void p9_peer(const Frame& F, const int l) {
    const int tid = fresh_tid(F.wave), lane = tid & 63, wave = __builtin_amdgcn_readfirstlane(tid >> 6);
    const unsigned char* UTu = F.UTAB + (size_t)l * NEXP * ROWB; const unsigned char* VTu = F.VTAB + (size_t)l * NEXP * ROWB;
    for (int tokb = (blockIdx.x * 8 + wave) * NT; tokb < NTOK; tokb += gridDim.x * 8 * NT) {
        int lnn = lane; asm volatile("; addresses of this token pair are rebuilt here, not hoisted" : "+v"(lnn));
        const int half = lnn >> 5, lq = lnn & 31;
        LAS unsigned* listw = (LAS unsigned*)(F.lds + wave * 3072 + half * 512);
        LAS float* listg = (LAS float*)(F.lds + wave * 3072 + 1024 + half * 512);
        LAS float* actl = (LAS float*)(F.lds + wave * 3072 + 2048 + half * 512);
        const int tok = tokb + half;
        {
            LAS unsigned* keyl = (LAS unsigned*)actl;
            unsigned key[4]; float gg[4]; unsigned rk[4];
#pragma unroll
            for (int r = 0; r < 4; ++r) { const size_t ei = (size_t)tok * 128 + r * 32 + lq; key[r] = ((unsigned)F.SELI[ei] << 7) | (unsigned)(r * 32 + lq); gg[r] = F.SELG[ei]; keyl[r * 32 + lq] = key[r]; rk[r] = 0u; }
#pragma unroll 1
            for (int j = 0; j < 128; j += 4) { const u32x4 kk = *(const LAS u32x4*)(keyl + j);
#pragma unroll
                for (int q = 0; q < 4; ++q)
#pragma unroll
                    for (int r = 0; r < 4; ++r) rk[r] += (kk[q] < key[r]) ? 1u : 0u; }
#pragma unroll
            for (int r = 0; r < 4; ++r) { listw[rk[r]] = key[r] >> 7; listg[rk[r]] = gg[r]; }
        }
#define H_LOAD(buf, TABu, idv) do { const unsigned o_ = __umul24((unsigned)(idv), (unsigned)ROWB) + (unsigned)lq * 32u; buf.d[0] = *(const u32x4*)(TABu + o_); buf.d[1] = *(const u32x4*)(TABu + (o_ + 16u)); buf.s = *(const unsigned*)(TABu + (o_ + 1024u - (unsigned)lq * 28u)); } while (0)
#define H_LOAD4(buf, TABu, k) do { const u32x4 i4_ = *(const LAS u32x4*)(listw + (k)); H_LOAD(buf[0], TABu, i4_[0]); H_LOAD(buf[1], TABu, i4_[1]); H_LOAD(buf[2], TABu, i4_[2]); H_LOAD(buf[3], TABu, i4_[3]); } while (0)
        {
            RowH ra[4], rb[4];
            H_LOAD4(ra, UTu, 0);
            int hh[8], hl[8]; float shs[2];
#pragma unroll
            for (int t = 0; t < 2; ++t) {
                float hv[32]; float m = 0.f;
#pragma unroll
                for (int k = 0; k < 8; ++k) { const u32x2 a = *(const u32x2*)(F.HB + (size_t)tok * D + t * 1024 + k * 128 + lq * 4);
                    hv[4 * k] = bf_lo(a[0]); hv[4 * k + 1] = bf_hi(a[0]); hv[4 * k + 2] = bf_lo(a[1]); hv[4 * k + 3] = bf_hi(a[1]); }
#pragma unroll
                for (int i = 0; i < 32; ++i) m = fmaxf(m, fabsf(hv[i]));
                const float sh = m > 0.f ? m * (1.0f / 119.0f) : 1.0f, ih = 1.0f / sh; shs[t] = sh;
#pragma unroll
                for (int dd = 0; dd < 4; ++dd) { unsigned ph = 0u, pl = 0u;
#pragma unroll
                    for (int n = 0; n < 8; ++n) { const int q = (int)rintf(hv[8 * dd + n] * ih); const int lo = ((q + 8) & 15) - 8, hi = (q - lo) >> 4;
                        ph |= (unsigned)(hi & 15) << (4 * n); pl |= (unsigned)(lo & 15) << (4 * n); }
                    hh[t * 4 + dd] = (int)ph; hl[t * 4 + dd] = (int)pl; }
            }
#pragma unroll 1
            for (int k0 = 0; k0 < 128; k0 += 8) {
                float pp[8];
                H_LOAD4(rb, UTu, k0 + 4);
#pragma unroll
                for (int q = 0; q < 4; ++q) { pp[q] = dot64i(ra[q], hh, hl, shs); }
                if (k0 != 120) H_LOAD4(ra, UTu, k0 + 8);
#pragma unroll
                for (int q = 0; q < 4; ++q) { pp[4 + q] = dot64i(rb[q], hh, hl, shs); }
                { const float t = reduce8h(pp, lq); if ((lq & 3) == 0) actl[k0 + (((lq >> 4) & 1) * 4 + ((lq >> 3) & 1) * 2 + ((lq >> 2) & 1))] = t; }
            }
        }
        RowH va[4], vb[4];
        H_LOAD4(va, VTu, 0);
#pragma unroll
        for (int r = 0; r < 4; ++r) { const int pos = r * 32 + lq; const float act = actl[pos]; listg[pos] = listg[pos] * 0.5f * act * (1.0f + erff(act * 0.70710678118654752f)); }
        h2v o[32];
#pragma unroll
        for (int j = 0; j < 32; ++j) o[j] = (h2v){(_Float16)0.f, (_Float16)0.f};
        {
#define H_AXPY4(buf, k) do { const f32x4 w4_ = *(const LAS f32x4*)(listg + (k)); _Pragma("unroll") for (int q = 0; q < 4; ++q) { axpy64(buf[q], o, w4_[q]); __builtin_amdgcn_sched_barrier(0); } } while (0)
#pragma unroll 1
            for (int k0 = 0; k0 < 128; k0 += 8) {
                H_LOAD4(vb, VTu, k0 + 4);
                H_AXPY4(va, k0);
                if (k0 != 120) H_LOAD4(va, VTu, k0 + 8);
                H_AXPY4(vb, k0 + 4);
            }
        }
#undef H_LOAD4
#undef H_AXPY4
#undef H_LOAD
        {
            int le = lq; asm volatile("; epilogue addresses rebuilt per token" : "+v"(le));
            const int grp = (tok < TP) ? 0 : 1 + ((tok - TP) >> 11);
            const float* md = F.MOD + (size_t)(l * 3 + grp) * 12288;
            float* xr = F.X + (size_t)tok * D + le * 4;
            f32x4 xn[16]; float ss = 0.f;
#pragma unroll
            for (int t = 0; t < 2; ++t)
#pragma unroll
                for (int k = 0; k < 8; ++k) { float* xp = xr + t * 1024 + k * 128;
                    const f32x4 xa = *(const f32x4*)xp, ga = *(const f32x4*)(md + 10240 + le * 4 + t * 1024 + k * 128);
                    const f32x4 ov = {(float)o[t * 16 + 2 * k].x, (float)o[t * 16 + 2 * k].y, (float)o[t * 16 + 2 * k + 1].x, (float)o[t * 16 + 2 * k + 1].y};
                    const f32x4 v = xa + ga * ov; xn[t * 8 + k] = v; ss += v[0] * v[0] + v[1] * v[1] + v[2] * v[2] + v[3] * v[3];
                    if (l < 3) *(f32x4*)xp = v; }
            ss = half_sum(ss);
            const float rstd = __frsqrt_rn(ss * (1.0f / 2048.0f) + EPS);
            if (l < 3) {
                const float* nw = F.norm_w + (size_t)(l + 1) * 2 * D; const float* mn = F.MOD + (size_t)((l + 1) * 3 + grp) * 12288;
#pragma unroll
                for (int t = 0; t < 2; ++t)
#pragma unroll
                    for (int k = 0; k < 8; ++k) { const int cidx = le * 4 + t * 1024 + k * 128;
                        const f32x4 nv = *(const f32x4*)(nw + cidx), sc = *(const f32x4*)(mn + 2048 + cidx), sh = *(const f32x4*)(mn + cidx);
                        const f32x4 hv = xn[t * 8 + k] * rstd * nv * (1.0f + sc) + sh;
                        *(u32x2*)(F.HB + (size_t)tok * D + cidx) = (u32x2){pk_bf16(hv[0], hv[1]), pk_bf16(hv[2], hv[3])}; }
            } else {
                float* yo = F.out + (size_t)tok * D + le * 4;
#pragma unroll
                for (int t = 0; t < 2; ++t)
#pragma unroll
                    for (int k = 0; k < 8; ++k) { const f32x4 na = *(const f32x4*)(F.final_norm_w + le * 4 + t * 1024 + k * 128); *(f32x4*)(yo + t * 1024 + k * 128) = xn[t * 8 + k] * rstd * na; }
            }
        }
    }
}

__global__ void __launch_bounds__(512, 2) mk_fwd(Args args) {
    extern __shared__ __attribute__((aligned(16))) unsigned char lds_raw[];
    Frame F;
    F.lds = (LAS unsigned char*)lds_raw; F.tid = threadIdx.x; F.lane = F.tid & 63; F.wave = __builtin_amdgcn_readfirstlane(F.tid >> 6);
    F.x_prompt = args.in[0]; F.x_sample = args.in[1]; F.state_in = args.in[2]; F.c = args.in[3]; F.c_ctx = args.in[4]; F.w_ada = args.in[5]; F.b_ada = args.in[6]; F.norm_w = args.in[7];
    F.w_in = args.in[8]; F.lower_bounds = args.in[9]; F.hgrn_norm_w = args.in[10]; F.w_pool = args.in[11]; F.pool_scale = args.in[12]; F.w_out = args.in[13]; F.w_query = args.in[14];
    F.sub_keys = args.in[15]; F.expert_u = args.in[16]; F.expert_v = args.in[17]; F.final_norm_w = args.in[18];
    unsigned char* ws = args.ws; F.out = args.out;
    F.MOD = (float*)(ws + WS_MOD); F.LB = (float*)(ws + WS_LB); F.WIN = (bf16_t*)(ws + WS_WIN); F.WOUT = (bf16_t*)(ws + WS_WOUT); F.WQ = (bf16_t*)(ws + WS_WQ); F.WINU = (bf16_t*)(ws + WS_WINU);
    F.WPOOL = (bf16_t*)(ws + WS_WPOOL); F.KEYS = (bf16_t*)(ws + WS_KEYS); F.UTAB = ws + WS_UTAB; F.VTAB = ws + WS_VTAB; F.USC = (float*)(ws + WS_USC); F.VSC = (float*)(ws + WS_VSC); F.X = (float*)(ws + WS_X); F.HB = (bf16_t*)(ws + WS_HB);
    F.P = (bf16_t*)(ws + WS_P); F.OF = (float*)(ws + WS_OF); F.OB = (float*)(ws + WS_OB); F.CAT = (bf16_t*)(ws + WS_CAT); F.Q = (bf16_t*)(ws + WS_Q); F.SELI = (int*)(ws + WS_SELI); F.SELG = (float*)(ws + WS_SELG); F.MODP = (float*)(ws + WS_MODP); F.QH = (bf16_t*)(ws + WS_QH); F.SSEG = (float*)(ws + WS_SSEG); F.DSEG = (float*)(ws + WS_DSEG);
    const int lo = args.ph_lo, hi = args.ph_hi;
    volatile LAS unsigned* misc = (volatile LAS unsigned*)(F.lds + MISC_OFF);
    if (F.tid < 4) misc[F.tid] = 0u;
    __syncthreads();
    XcdBarrier bar; bar.bar = (unsigned*)(ws + WS_CTL); bar.x = 0; bar.st = misc;
    if (hi - lo > 1) bar = xcd_barrier_post((unsigned*)(ws + WS_CTL), misc);
#define IN(k) (lo <= (k) && (k) < hi)
#define SEAM(k) do { if ((k) + 1 < hi) xcd_barrier(bar); } while (0)
    const int G = gridDim.x, bx = blockIdx.x;
    if (IN(0)) { for (int rep = 0; rep < NREP(0); ++rep) { if (KIND_ON(0)) p0_prologue(F); __syncthreads(); } SEAM(0); }
    if (IN(1)) {
        if (KIND_ON(1)) {
            pg8::Gemm g{F.WPOOL, F.WINU, 4096, 32768, 256, 256, 256}; pg8::PoolFoldOrder S{G, bx}; pg8::EpiPoolFold E{F.WIN};
            pg8::gemm_phase<pg8::EpiPoolFold, pg8::PoolFoldOrder>(F.lds, g, S, E, F.wave);
        }
        if (KIND_ON(6)) {
            for (int i = bx * 512 + fresh_tid(F.wave); i < 4 * 3 * 12288; i += G * 512) F.MOD[i] = ((F.MODP[i] + F.MODP[MODP_STRIDE + i]) + F.MODP[2 * MODP_STRIDE + i]) + F.MODP[3 * MODP_STRIDE + i];
            norm_rows<4>(F, F.x_prompt, F.x_sample, F.norm_w, F.MODP, 0, 2048);
        }
        SEAM(1);
    }
    for (int l = 0; l < 4; ++l) {
        const int pb = 2 + 9 * l;
        if (IN(pb) && KIND_ON(2)) for (int rep = 0; rep < NREP(2); ++rep) {
            pg8::Gemm g{F.HB, F.WIN + (size_t)l * 6144 * 2048, NTOK, DIN, D, D, D}; pg8::StaticOrder S; S.init(NTOK, DIN, G, bx); pg8::EpiBf16 E{F.P, DIN};
            pg8::gemm_phase<pg8::EpiBf16, pg8::StaticOrder>(F.lds, g, S, E, F.wave);
            if (rep == NREP(2) - 1) SEAM(pb);
        }
        if (IN(pb + 1)) { for (int rep = 0; rep < NREP(3); ++rep) { if (KIND_ON(3)) p3_scan(F, l); __syncthreads(); } SEAM(pb + 1); }
        if (IN(pb + 2)) { if (KIND_ON(3)) p3c_correct(F, l); SEAM(pb + 2); }
        if (IN(pb + 3)) { for (int rep = 0; rep < NREP(4); ++rep) if (KIND_ON(4)) p4_combine(F, l); SEAM(pb + 3); }
        if (IN(pb + 4) && KIND_ON(5)) {
            pg8::Gemm g{F.CAT, F.WOUT + (size_t)l * D * D, NTOK, D, D, D, D}; pg8::StaticOrder S; S.init(NTOK, D, G, bx);
            pg8::EpiRes E{l == 0 ? F.x_prompt : F.X, l == 0 ? F.x_sample : F.X + (size_t)TP * D, F.X, F.MOD + (size_t)l * 3 * 12288 + 4096};
            pg8::gemm_phase<pg8::EpiRes, pg8::StaticOrder>(F.lds, g, S, E, F.wave);
            SEAM(pb + 4);
        }
        if (IN(pb + 5)) { for (int rep = 0; rep < NREP(6); ++rep) if (KIND_ON(6)) norm_rows<1>(F, F.X, F.X + (size_t)TP * D, F.norm_w + (size_t)(l * 2 + 1) * D, F.MOD + (size_t)l * 3 * 12288, 6144, 8192); SEAM(pb + 5); }
        if (IN(pb + 6) && KIND_ON(7)) {
            pg8::Gemm g{F.HB, F.WQ + (size_t)l * D * D, NTOK, D, D, D, D}; pg8::StaticOrder S; S.init(NTOK, D, G, bx); pg8::EpiBf16 E{F.Q, D};
            const bool early = (bx >> 3) & 1, odd = F.wave & 1;
#pragma unroll 1
            for (int st = 0; st < 4; ++st) {
                if (st == 1) {
                    pg8::gemm_phase<pg8::EpiBf16, pg8::StaticOrder>(F.lds, g, S, E, F.wave);
                    asm volatile("s_waitcnt vmcnt(0)" ::: "memory");
                    __syncthreads();
                    if (F.tid == 0) { __builtin_amdgcn_fence(__ATOMIC_ACQUIRE, "agent"); asm volatile("s_waitcnt vmcnt(0)" ::: "memory"); }
                    __syncthreads();
                    continue;
                }
                const bool cv = early ? (st == 0) : ((st == 2 && !odd) || (st == 3 && odd));
                const bool tk = early ? (st == 2) : ((st == 2 && odd) || (st == 3 && !odd));
                if (cv && KIND_ON(8)) conv_tables(F, l);
                if (tk && KIND_ON(8)) p8_topk(F, l, S);
            }
            SEAM(pb + 6);
        }
        if (IN(pb + 8)) { if (KIND_ON(9)) p9_peer(F, l); SEAM(pb + 8); }
    }
}

extern "C" void kernel_launch(void* const* d_in, const int* in_sizes, int n_in, void* d_out, int out_size, void* d_ws, size_t ws_size, hipStream_t stream) {
    static int grid = 0;
    if (grid == 0) {
        if (n_in != 19 || ws_size < WS_END) { fprintf(stderr, "kernel_launch: expected 19 inputs and >= %zu bytes of workspace, got %d / %zu\n", (size_t)WS_END, n_in, ws_size); grid = -1; return; }
        int dev = 0, cus = 0, per_cu = 0;
        if (hipGetDevice(&dev) != hipSuccess || hipDeviceGetAttribute(&cus, hipDeviceAttributeMultiprocessorCount, dev) != hipSuccess) { grid = -1; return; }
        if (hipFuncSetAttribute((const void*)mk_fwd, hipFuncAttributeMaxDynamicSharedMemorySize, LDS_BYTES) != hipSuccess) { fprintf(stderr, "kernel_launch: hipFuncSetAttribute failed\n"); grid = -1; return; }
        if (hipOccupancyMaxActiveBlocksPerMultiprocessor(&per_cu, (const void*)mk_fwd, 512, LDS_BYTES) != hipSuccess || per_cu < 1) { fprintf(stderr, "kernel_launch: occupancy query says %d\n", per_cu); }
        (void)hipGetLastError();
        grid = cus;
    }
    if (grid < 0) return;
    (void)hipMemsetAsync((char*)d_ws + WS_CTL, 0, WS_MOD - WS_CTL, stream);
    Args a{};
    for (int i = 0; i < 19; ++i) a.in[i] = (const float*)d_in[i];
    a.out = (float*)d_out; a.ws = (unsigned char*)d_ws;
#if MK_ONE_LAUNCH
    a.ph_lo = 0; a.ph_hi = NPHASE;
    hipLaunchKernelGGL(mk_fwd, dim3(grid), dim3(512), LDS_BYTES, stream, a);
#else
    for (int ph = 0; ph < NPHASE; ++ph) { a.ph_lo = ph; a.ph_hi = ph + 1; hipLaunchKernelGGL(mk_fwd, dim3(grid), dim3(512), LDS_BYTES, stream, a); }
#endif
}
```

```cpp
#include <hip/hip_runtime.h>
#include <cstdio>
#include <cstdint>

#ifndef MK_ONE_LAUNCH
#define MK_ONE_LAUNCH 1
#endif
#ifndef MK_KIND_MASK
#define MK_KIND_MASK 0x3ff
#endif
#define KIND_ON(k) (((MK_KIND_MASK) >> (k)) & 1)
#ifndef MK_REPEAT_MASK
#define MK_REPEAT_MASK 0
#endif
#define NREP(k) (1 + (((MK_REPEAT_MASK) >> (k)) & 1))

#define DI __device__ __forceinline__
#define LAS __attribute__((address_space(3)))

typedef unsigned short bf16_t;
typedef short bf16x8 __attribute__((ext_vector_type(8)));
typedef float f32x2 __attribute__((ext_vector_type(2)));
typedef float f32x4 __attribute__((ext_vector_type(4)));
typedef float f32x16 __attribute__((ext_vector_type(16)));
typedef unsigned u32x2 __attribute__((ext_vector_type(2)));
typedef unsigned u32x4 __attribute__((ext_vector_type(4)));
typedef unsigned u32x6 __attribute__((ext_vector_type(6)));
typedef float f32x32 __attribute__((ext_vector_type(32)));
typedef _Float16 h2v __attribute__((ext_vector_type(2)));
typedef _Float16 h32v __attribute__((ext_vector_type(32)));
typedef __bf16 bf16x2_t __attribute__((ext_vector_type(2)));

constexpr int D = 2048, NTOK = 8192, TP = 4096, DIN = 6144, NMOD = 12288, NEXP = 16384;
constexpr float EPS = 1e-6f;
constexpr int NPHASE = 38;
constexpr int ROWB = 1152;

constexpr size_t WS_CTL = 0;
constexpr size_t WS_MOD = 65536;
constexpr size_t WS_LB = WS_MOD + (size_t)4 * 3 * 12288 * 4;
constexpr size_t WS_WIN = WS_LB + (size_t)2 * 4 * 1024 * 4;
constexpr size_t WS_WOUT = WS_WIN + (size_t)4 * 6144 * 2048 * 2;
constexpr size_t WS_WQ = WS_WOUT + (size_t)4 * 2048 * 2048 * 2;
constexpr size_t WS_WINU = WS_WQ + (size_t)4 * 2048 * 2048 * 2;
constexpr size_t WS_WPOOL = WS_WINU + (size_t)16 * 2048 * 256 * 2;
constexpr size_t WS_KEYS = WS_WPOOL + (size_t)16 * 256 * 256 * 2;
constexpr size_t WS_UTAB = WS_KEYS + (size_t)4 * 8 * 2 * 128 * 128 * 2;
constexpr size_t WS_VTAB = WS_UTAB + (size_t)4 * 16384 * 2048;
constexpr size_t WS_X = WS_VTAB + (size_t)4 * 16384 * 2048;
constexpr size_t WS_HB = WS_X + (size_t)8192 * 2048 * 4;
constexpr size_t WS_P = WS_HB + (size_t)8192 * 2048 * 2;
constexpr size_t WS_OF = WS_P + (size_t)8192 * 6144 * 2;
constexpr size_t WS_OB = WS_OF + (size_t)8192 * 1024 * 4;
constexpr size_t WS_CAT = WS_OB + (size_t)8192 * 1024 * 4;
constexpr size_t WS_Q = WS_CAT + (size_t)8192 * 2048 * 2;
constexpr size_t WS_SELI = WS_Q + (size_t)8192 * 2048 * 2;
constexpr size_t WS_SELG = WS_SELI + (size_t)8192 * 128 * 4;
constexpr size_t WS_MODP = WS_SELG + (size_t)8192 * 128 * 4;
constexpr size_t WS_USC = WS_MODP + (size_t)4 * 4 * 3 * 12288 * 4;
constexpr size_t WS_VSC = WS_USC + (size_t)4 * 16384 * 4;
constexpr size_t WS_QH = WS_VSC + (size_t)4 * 16384 * 4;
constexpr size_t WS_SSEG = WS_QH + (size_t)2 * 4096 * 1024 * 2;
constexpr size_t WS_DSEG = WS_SSEG + (size_t)256 * 16384 * 4;
constexpr size_t WS_END = WS_DSEG + (size_t)256 * 128 * 4;
constexpr size_t MODP_STRIDE = (size_t)4 * 3 * 12288;

constexpr int LDS_BYTES = 155648;
constexpr int MISC_OFF = LDS_BYTES - 256;

DI unsigned pk_bf16(float lo, float hi) { f32x2 v = {lo, hi}; bf16x2_t b = __builtin_convertvector(v, bf16x2_t); return __builtin_bit_cast(unsigned, b); }
DI float bf_lo(unsigned x) { return __uint_as_float(x << 16); }
DI float bf_hi(unsigned x) { return __uint_as_float(x & 0xffff0000u); }
template <int M> DI float xshfl(float v) {
    if constexpr (M < 32) return __int_as_float(__builtin_amdgcn_ds_swizzle(__float_as_int(v), (M << 10) | 0x1f));
    else { unsigned z = 0u; asm volatile("; rebuilt at each use, never kept" : "+v"(z)); const unsigned ad = (__builtin_amdgcn_mbcnt_hi(~0u, __builtin_amdgcn_mbcnt_lo(~0u, z)) ^ 32u) << 2; return __int_as_float(__builtin_amdgcn_ds_bpermute((int)ad, __float_as_int(v))); }
}
DI float wave_sum(float v) { v += xshfl<32>(v); v += xshfl<16>(v); v += xshfl<8>(v); v += xshfl<4>(v); v += xshfl<2>(v); v += xshfl<1>(v); return v; }
DI float fdot2(unsigned a, unsigned b, float c) { return __builtin_amdgcn_fdot2_f32_bf16(__builtin_bit_cast(bf16x2_t, a), __builtin_bit_cast(bf16x2_t, b), c, false); }
DI float silu_f(float x) { return x / (1.f + __expf(-x)); }
#define MFMA32(a, b, c) __builtin_amdgcn_mfma_f32_32x32x16_bf16((a), (b), (c), 0, 0, 0)
DI int fresh_tid(const int wave_s) { unsigned z = 0u; asm volatile("; fresh lane id" : "+v"(z)); const int t = (int)__builtin_amdgcn_mbcnt_hi(~0u, __builtin_amdgcn_mbcnt_lo(~0u, z)); return (wave_s << 6) | t; }
DI int crow(int i, int hh) { return (i & 3) + 8 * (i >> 2) + 4 * hh; }

#define XB_TMO      128
#define XB_XCNT(j)  (256  + 64 * (j))
#define XB_XSUB(j)  (1280 + 64 * (j))
#define XB_XGEN(j)  (2304 + 64 * (j))
#define XB_TOP      3328
#define XB_TOPGEN   3392
#define XCD_BAR_WORDS 3456
#define XB_SPIN_CAP (1u << 18)

__device__ __forceinline__ unsigned xb_ld(unsigned* p)              { return __hip_atomic_load(p, __ATOMIC_RELAXED, __HIP_MEMORY_SCOPE_AGENT); }
__device__ __forceinline__ unsigned xb_add(unsigned* p, unsigned v) { return __hip_atomic_fetch_add(p, v, __ATOMIC_RELAXED, __HIP_MEMORY_SCOPE_AGENT); }
__device__ __forceinline__ unsigned xb_xcc_id() { return (unsigned)__builtin_amdgcn_s_getreg((3 << 11) | 20) & 0xFu; }
#define XB_SPIN(cond, bar) do { unsigned _sp = 0; while (cond) { __builtin_amdgcn_s_sleep(1); \
    if ((++_sp & 255u) == 0u) { if (xb_ld(&(bar)[XB_TMO])) break; if (_sp > XB_SPIN_CAP) { atomicAdd(&(bar)[XB_TMO], 1u); break; } } } } while (0)

struct XcdBarrier {
    unsigned* bar; unsigned x;
    volatile LAS unsigned* st;
};
__device__ __forceinline__ XcdBarrier xcd_barrier_post(unsigned* bar, volatile LAS unsigned* st) {
    XcdBarrier b; b.bar = bar; b.x = xb_xcc_id(); b.st = st;
    if (threadIdx.x == 0) (void)xb_add(&bar[XB_XCNT(b.x)], 1u);
    return b;
}
__device__ __forceinline__ void xcd_barrier_complete(unsigned* bar, unsigned x, unsigned& nloc, unsigned& nx) {
    const unsigned G = gridDim.x * gridDim.y * gridDim.z;
    unsigned sum, cnt, mine, sp = 0u;
    for (;;) {
        sum = 0u; cnt = 0u; mine = 0u;
#pragma unroll
        for (unsigned j = 0; j < 16; ++j) { const unsigned c = xb_ld(&bar[XB_XCNT(j)]); sum += c; cnt += (c > 0u) ? 1u : 0u; mine = (j == x) ? c : mine; }
        if (sum == G) break;
        __builtin_amdgcn_s_sleep(1);
        if ((++sp & 255u) == 0u) { if (xb_ld(&bar[XB_TMO])) break; if (sp > XB_SPIN_CAP) { atomicAdd(&bar[XB_TMO], 1u); break; } }
    }
    nloc = mine > 0u ? mine : 1u; nx = cnt > 0u ? cnt : 1u;
}
__device__ __forceinline__ void xcd_barrier(const XcdBarrier& b) {
    asm volatile("s_waitcnt vmcnt(0)" ::: "memory");
    __syncthreads();
    if (threadIdx.x == 0) {
        unsigned* bar = b.bar;
        __builtin_amdgcn_s_waitcnt(0);
        unsigned nloc = b.st[0], nx = b.st[1];
        if (nloc == 0u) { xcd_barrier_complete(bar, b.x, nloc, nx); b.st[0] = nloc; b.st[1] = nx; }
        const unsigned old = xb_add(&bar[XB_XSUB(b.x)], 1u);
        const unsigned gen = old / nloc;
        if (old + 1u == (gen + 1u) * nloc) {
            __builtin_amdgcn_fence(__ATOMIC_RELEASE, "agent");
            asm volatile("s_waitcnt vmcnt(0)" ::: "memory");
            const unsigned og = xb_add(&bar[XB_TOP], 1u);
            const unsigned tg = og / nx;
            if (og + 1u == (tg + 1u) * nx) xb_add(&bar[XB_TOPGEN], 1u);
            else XB_SPIN(xb_ld(&bar[XB_TOPGEN]) == tg, bar);
            __builtin_amdgcn_fence(__ATOMIC_ACQUIRE, "agent");
            xb_add(&bar[XB_XGEN(b.x)], 1u);
            asm volatile("s_waitcnt vmcnt(0)" ::: "memory");
        } else {
            XB_SPIN(xb_ld(&bar[XB_XGEN(b.x)]) == gen, bar);
            __builtin_amdgcn_fence(__ATOMIC_ACQUIRE, "agent");
            asm volatile("s_waitcnt vmcnt(0)" ::: "memory");
        }
    }
    __syncthreads();
}

namespace pg8 {
constexpr int BM = 256, BK = 64, HALF = 128, HTB = HALF * BK * 2, STAGE_BYTES = 8 * HTB, NXCD = 8, WGM = 8;
__host__ __device__ __forceinline__ int lds_byte(int r, int c) { const int st = (r >> 4) * 2 + (c >> 5), rr = r & 15, cc = c & 31, ob = rr * 64 + cc * 2; return st * 1024 + (ob ^ (((ob >> 9) & 1) << 5)); }
__host__ __device__ __forceinline__ void stage_rc(int b, int& R, int& C) { const int st = b / 1024, sb = b % 1024, swz = sb ^ (((sb >> 9) & 1) << 5); R = (st >> 1) * 16 + swz / 64; C = (st & 1) * 32 + (swz % 64) / 2; }
__host__ __device__ __forceinline__ int perm32(int rho) { const int n = rho >> 4, i = rho & 15; return 8 * (i >> 2) + 4 * n + (i & 3); }

struct Unit { int pm, pn; };
struct Gemm { const bf16_t* A; const bf16_t* Bt; int M, N, K, lda, ldb; };

struct StaticOrder {
    int nM, nN, nwg, G, c;
    __host__ __device__ void init(int M, int N, int G_, int c_) { nM = M / BM; nN = N / BM; nwg = nM * nN; G = G_; c = c_; }
    __host__ __device__ bool next(int i, Unit& u) const {
        const long L = (long)i * G + c; if (L >= nwg) return false;
        int wgid = (int)L; { const int q = nwg / NXCD, r = nwg % NXCD, xcd = wgid % NXCD, off = wgid / NXCD; wgid = (xcd < r ? xcd * (q + 1) : r * (q + 1) + (xcd - r) * q) + off; }
        const int nig = WGM * nN, gid = wgid / nig, fm = gid * WGM, gsz = (nM - fm) < WGM ? (nM - fm) : WGM;
        u.pm = fm + ((wgid % nig) % gsz); u.pn = (wgid % nig) / gsz; return true;
    }
    __device__ __forceinline__ void a_ready(const Unit&) const {}
    __device__ __forceinline__ void done(const Unit&) const {}
};
struct PoolFoldOrder {
    int G, c;
    __device__ bool next(int i, Unit& u) const { const int L = i * G + c; if (L >= 128) return false; u.pm = L >> 3; u.pn = L; return true; }
    __device__ __forceinline__ void a_ready(const Unit&) const {}
    __device__ __forceinline__ void done(const Unit&) const {}
};

struct EpiBf16 {
    static constexpr bool PERM = true, AFTER_DRAIN = false;
    bf16_t* O; int ldc;
    __device__ __forceinline__ void operator()(const f32x4 (&acc)[2][2][4][2], const Unit& u, int wr, int wc, int fr, int fq) const {
        const int row0 = u.pm * BM + wr * 64 + fr; const int col0 = u.pn * BM + wc * 32 + 8 * fq;
#pragma unroll
        for (int ai = 0; ai < 2; ++ai)
#pragma unroll
            for (int m = 0; m < 4; ++m) { bf16_t* rowp = O + (size_t)(row0 + ai * HALF + m * 16) * ldc + col0;
#pragma unroll
                for (int bj = 0; bj < 2; ++bj) { const f32x4 v0 = acc[ai][bj][m][0], v1 = acc[ai][bj][m][1];
                    u32x4 w; w.x = pk_bf16(v0[0], v0[1]); w.y = pk_bf16(v0[2], v0[3]); w.z = pk_bf16(v1[0], v1[1]); w.w = pk_bf16(v1[2], v1[3]);
                    *(u32x4*)(rowp + bj * HALF) = w; } }
    }
};
struct EpiPoolFold {
    static constexpr bool PERM = true, AFTER_DRAIN = false;
    bf16_t* WIN;
    __device__ __forceinline__ void operator()(const f32x4 (&acc)[2][2][4][2], const Unit& u, int wr, int wc, int fr, int fq) const {
        const int lg = u.pm, l = lg >> 2, g = lg & 3, kt = u.pn & 7;
        bf16_t* base = WIN + ((size_t)l * 6144 + 5120 + g * 256) * 2048 + kt * 256;
        const int row0 = wr * 64 + fr, col0 = wc * 32 + 8 * fq;
#pragma unroll
        for (int ai = 0; ai < 2; ++ai)
#pragma unroll
            for (int m = 0; m < 4; ++m) { bf16_t* rowp = base + (size_t)(row0 + ai * HALF + m * 16) * 2048 + col0;
#pragma unroll
                for (int bj = 0; bj < 2; ++bj) { const f32x4 v0 = acc[ai][bj][m][0], v1 = acc[ai][bj][m][1];
                    u32x4 w; w.x = pk_bf16(v0[0], v0[1]); w.y = pk_bf16(v0[2], v0[3]); w.z = pk_bf16(v1[0], v1[1]); w.w = pk_bf16(v1[2], v1[3]);
                    *(u32x4*)(rowp + bj * HALF) = w; } }
    }
};
struct EpiRes {
    static constexpr bool PERM = true, AFTER_DRAIN = false;
    const float* xin_p; const float* xin_s; const bf16_t* xin_b; bf16_t* xout; const float* gate;
    __device__ __forceinline__ void operator()(const f32x4 (&acc)[2][2][4][2], const Unit& u, int wr, int wc, int fr, int fq) const {
        const int row0 = u.pm * BM + wr * 64 + fr, col0 = u.pn * BM + wc * 32 + 8 * fq;
        const int grp = (u.pm < 16) ? 0 : 1 + ((u.pm - 16) >> 3);
        const float* gp = gate + (size_t)grp * 12288 + col0;
        f32x4 gv[2][2];
#pragma unroll
        for (int bj = 0; bj < 2; ++bj)
#pragma unroll
            for (int n = 0; n < 2; ++n) gv[bj][n] = *(const f32x4*)(gp + bj * HALF + n * 4);
#pragma unroll
        for (int ai = 0; ai < 2; ++ai)
#pragma unroll
            for (int m = 0; m < 4; ++m) { const int row = row0 + ai * HALF + m * 16;
#pragma unroll
                for (int bj = 0; bj < 2; ++bj) { f32x4 x0, x1;
                    if (xin_b) { const u32x4 w = *(const u32x4*)(xin_b + (size_t)row * D + col0 + bj * HALF); x0 = (f32x4){bf_lo(w.x), bf_hi(w.x), bf_lo(w.y), bf_hi(w.y)}; x1 = (f32x4){bf_lo(w.z), bf_hi(w.z), bf_lo(w.w), bf_hi(w.w)}; }
                    else { const float* xi = (row < TP ? xin_p + (size_t)row * D : xin_s + (size_t)(row - TP) * D) + col0 + bj * HALF; x0 = *(const f32x4*)xi; x1 = *(const f32x4*)(xi + 4); }
                    const f32x4 r0 = x0 + gv[bj][0] * acc[ai][bj][m][0], r1 = x1 + gv[bj][1] * acc[ai][bj][m][1];
                    u32x4 o; o.x = pk_bf16(r0[0], r0[1]); o.y = pk_bf16(r0[2], r0[3]); o.z = pk_bf16(r1[0], r1[1]); o.w = pk_bf16(r1[2], r1[3]);
                    *(u32x4*)(xout + (size_t)row * D + col0 + bj * HALF) = o; } }
    }
};

template <class Epi, class Sched>
__device__ __forceinline__ void gemm_phase(LAS unsigned char* lds, const Gemm g, const Sched& S, const Epi& E, const int wave_s) {
    const int tid = fresh_tid(wave_s), wid = __builtin_amdgcn_readfirstlane(tid >> 6), lane = tid & 63, wr = wid >> 2, wc = wid & 3, fr = lane & 15, fq = lane >> 4;
    const int K = g.K, nt = K / BK;
    unsigned voffA[2], voffB[2];
#pragma unroll
    for (int i = 0; i < 2; ++i) { int R, C; stage_rc(tid * 16 + i * 8192, R, C); const int Rb = Epi::PERM ? ((R & ~31) + perm32(R & 31)) : R;
        voffA[i] = (unsigned)(R * g.lda + C) * 2u; voffB[i] = (unsigned)(Rb * g.ldb + C) * 2u; }
    const size_t kstep = (size_t)(BK * 2);
    const size_t hstepA = (size_t)HALF * g.lda * 2, hstepB = (size_t)HALF * g.ldb * 2;
    const size_t tstepA = 2 * hstepA, tstepB = 2 * hstepB;
    const unsigned ldsw = (unsigned)wid * 1024u;
    const int aoff = lds_byte(wr * 64 + fr, fq * 8), boff = lds_byte(wc * 32 + fr, fq * 8);
#define PG8_SA(b, h) (((b) * 2 + (h)) * HTB)
#define PG8_SB(b, h) ((4 + (b) * 2 + (h)) * HTB)
#define PG8_STAGE(bufoff, gbase, voff) do { _Pragma("unroll") for (int _i = 0; _i < 2; ++_i) \
        __builtin_amdgcn_global_load_lds((const unsigned*)((const char*)(gbase) + (voff)[_i]), (LAS unsigned*)(lds + (bufoff) + ldsw + _i * 8192), 16, 0, 0); } while (0)
#define PG8_LDA(dst, b, h) do { _Pragma("unroll") for (int m = 0; m < 4; ++m) _Pragma("unroll") for (int k = 0; k < 2; ++k) dst[m][k] = *(const LAS bf16x8*)(lds + PG8_SA(b, h) + aoff + m * 2048 + k * 1024); } while (0)
#define PG8_LDB(dst, b, h) do { _Pragma("unroll") for (int n = 0; n < 2; ++n) _Pragma("unroll") for (int k = 0; k < 2; ++k) dst[n][k] = *(const LAS bf16x8*)(lds + PG8_SB(b, h) + boff + n * 2048 + k * 1024); } while (0)
#define PG8_MMA(ai, bj, At, Bt) do { __builtin_amdgcn_s_setprio(1); _Pragma("unroll") for (int m = 0; m < 4; ++m) _Pragma("unroll") for (int n = 0; n < 2; ++n) _Pragma("unroll") for (int k = 0; k < 2; ++k) \
        acc[ai][bj][m][n] = __builtin_amdgcn_mfma_f32_16x16x32_bf16(Bt[n][k], At[m][k], acc[ai][bj][m][n], 0, 0, 0); __builtin_amdgcn_s_setprio(0); } while (0)
#define PG8_WAIT_V(n) asm volatile("s_waitcnt vmcnt(" #n ")" ::: "memory")
#define PG8_WAIT_L(n) asm volatile("s_waitcnt lgkmcnt(" #n ")" ::: "memory")
#define PG8_BAR __builtin_amdgcn_s_barrier()
#define PG8_SCHED __builtin_amdgcn_sched_barrier(0)
    Unit cur, nxt; int ui = 0;
    if (!S.next(0, cur)) return;
    f32x4 acc[2][2][4][2];
#pragma unroll
    for (int a = 0; a < 2; ++a)
#pragma unroll
        for (int b = 0; b < 2; ++b)
#pragma unroll
            for (int m = 0; m < 4; ++m)
#pragma unroll
                for (int n = 0; n < 2; ++n) acc[a][b][m][n] = (f32x4){0.f, 0.f, 0.f, 0.f};
    bf16x8 At[4][2], B0[2][2], B1[2][2];
    const char* cA = (const char*)g.A + (size_t)cur.pm * tstepA; const char* cB = (const char*)g.Bt + (size_t)cur.pn * tstepB;
    S.a_ready(cur);
    PG8_STAGE(PG8_SB(0, 0), cB, voffB); PG8_STAGE(PG8_SA(0, 0), cA, voffA); PG8_STAGE(PG8_SB(0, 1), cB + hstepB, voffB); PG8_STAGE(PG8_SA(0, 1), cA + hstepA, voffA);
    if (wr == 1) PG8_BAR;
    PG8_WAIT_V(4); PG8_BAR;
    PG8_STAGE(PG8_SB(1, 0), cB + kstep, voffB); PG8_STAGE(PG8_SA(1, 0), cA + kstep, voffA); PG8_STAGE(PG8_SB(1, 1), cB + hstepB + kstep, voffB);
    PG8_WAIT_V(6); PG8_BAR;
    for (;;) {
        const bool has_next = S.next(ui + 1, nxt);
        const char* nA = has_next ? (const char*)g.A + (size_t)nxt.pm * tstepA : cA; const char* nB = has_next ? (const char*)g.Bt + (size_t)nxt.pn * tstepB : cB;
        for (int t = 0; t < nt; t += 2) {
            const bool last = (t == nt - 2);
            const char* a1 = cA + (size_t)(t + 1) * kstep;
            const char* a2 = last ? nA : cA + (size_t)(t + 2) * kstep; const char* b2 = last ? nB : cB + (size_t)(t + 2) * kstep;
            const char* a3 = a2 + kstep; const char* b3 = b2 + kstep;
            if (last && has_next) S.a_ready(nxt);
            PG8_LDB(B0, 0, 0); PG8_SCHED; PG8_LDA(At, 0, 0); PG8_STAGE(PG8_SA(1, 1), a1 + hstepA, voffA);
            PG8_WAIT_L(8); PG8_BAR; PG8_WAIT_L(0); PG8_MMA(0, 0, At, B0); PG8_BAR; PG8_SCHED;
            PG8_LDB(B1, 0, 1); PG8_STAGE(PG8_SB(0, 0), b2, voffB);
            PG8_BAR; PG8_WAIT_L(0); PG8_MMA(0, 1, At, B1); PG8_BAR;
            PG8_LDA(At, 0, 1); PG8_STAGE(PG8_SA(0, 0), a2, voffA);
            PG8_BAR; PG8_WAIT_L(0); PG8_MMA(1, 0, At, B0); PG8_BAR; PG8_SCHED;
            PG8_STAGE(PG8_SB(0, 1), b2 + hstepB, voffB);
            PG8_WAIT_V(6); PG8_BAR; PG8_MMA(1, 1, At, B1); PG8_BAR;
            PG8_LDB(B0, 1, 0); PG8_SCHED; PG8_LDA(At, 1, 0); PG8_STAGE(PG8_SA(0, 1), a2 + hstepA, voffA);
            PG8_WAIT_L(8); PG8_BAR; PG8_WAIT_L(0); PG8_MMA(0, 0, At, B0); PG8_BAR; PG8_SCHED;
            PG8_LDB(B1, 1, 1); PG8_STAGE(PG8_SB(1, 0), b3, voffB);
            PG8_BAR; PG8_WAIT_L(0); PG8_MMA(0, 1, At, B1); PG8_BAR;
            PG8_LDA(At, 1, 1); PG8_STAGE(PG8_SA(1, 0), a3, voffA);
            PG8_BAR; PG8_WAIT_L(0); PG8_MMA(1, 0, At, B0); PG8_BAR; PG8_SCHED;
            PG8_STAGE(PG8_SB(1, 1), b3 + hstepB, voffB);
            PG8_WAIT_V(6); PG8_BAR; PG8_MMA(1, 1, At, B1); PG8_BAR;
        }
        E(acc, cur, wr, wc, fr, fq); S.done(cur);
        if (!has_next) break;
#pragma unroll
        for (int a = 0; a < 2; ++a)
#pragma unroll
            for (int b = 0; b < 2; ++b)
#pragma unroll
                for (int m = 0; m < 4; ++m)
#pragma unroll
                    for (int n = 0; n < 2; ++n) acc[a][b][m][n] = (f32x4){0.f, 0.f, 0.f, 0.f};
        cur = nxt; cA = nA; cB = nB; ++ui;
    }
    PG8_WAIT_V(0);
    if (wr == 0) PG8_BAR;
    PG8_BAR;
#undef PG8_SA
#undef PG8_SB
#undef PG8_STAGE
#undef PG8_LDA
#undef PG8_LDB
#undef PG8_MMA
#undef PG8_WAIT_V
#undef PG8_WAIT_L
#undef PG8_BAR
#undef PG8_SCHED
}
}

struct Args { const float* in[19]; float* out; unsigned char* ws; int ph_lo, ph_hi; };
struct Frame {
    LAS unsigned char* lds; int tid, lane, wave;
    const float *x_prompt, *x_sample, *state_in, *c, *c_ctx, *w_ada, *b_ada, *norm_w, *w_in, *lower_bounds, *hgrn_norm_w, *w_pool, *pool_scale, *w_out, *w_query, *sub_keys, *expert_u, *expert_v, *final_norm_w;
    float* out; float* MOD; float* LB; bf16_t *WIN, *WOUT, *WQ, *WINU, *WPOOL, *KEYS; unsigned char *UTAB, *VTAB; float *USC, *VSC; float* X; bf16_t* XB; bf16_t *HB, *P; float *OF, *OB; bf16_t *CAT, *Q; int* SELI; float* SELG; float* MODP; bf16_t* QH; float *SSEG, *DSEG;
};

DI void p0_prologue(const Frame& F) {
    LAS float* sv = (LAS float*)(F.lds);
    LAS float* red = (LAS float*)(F.lds + 24576);
    LAS float* tile = (LAS float*)(F.lds + 49152);
    const int tid = fresh_tid(F.wave), lane = tid & 63, wave = __builtin_amdgcn_readfirstlane(tid >> 6), b = blockIdx.x, G = gridDim.x;
    for (int i = tid; i < 3 * 2048; i += 512) { const int g = i >> 11, k = i & 2047; const float cv = (g == 0) ? F.c_ctx[k] : F.c[(g - 1) * 2048 + k]; sv[i] = silu_f(cv); }
    __syncthreads();
    for (int task = b; task < 768; task += G) {
        const int l = task / 192, rem = task % 192, cb = rem >> 2, kq = rem & 3;
        const float* W = F.w_ada + (size_t)l * 2048 * 12288 + cb * 256 + lane * 4;
        const int r0 = kq * 512 + wave * 64;
        f32x4 a0 = {0.f, 0.f, 0.f, 0.f}, a1 = a0, a2 = a0;
#pragma unroll 8
        for (int r = r0; r < r0 + 64; ++r) {
            const f32x4 w = __builtin_nontemporal_load((const f32x4*)(W + (size_t)r * 12288));
            a0 += sv[r] * w; a1 += sv[2048 + r] * w; a2 += sv[4096 + r] * w;
        }
        LAS float* rp = red + (wave * 3) * 256 + lane * 4;
        *(LAS f32x4*)(rp) = a0; *(LAS f32x4*)(rp + 256) = a1; *(LAS f32x4*)(rp + 512) = a2;
        __syncthreads();
        for (int i = tid; i < 768; i += 512) { const int g = i >> 8, cc = i & 255; float s = 0.f;
#pragma unroll
            for (int w = 0; w < 8; ++w) s += red[(w * 3 + g) * 256 + cc];
            const int n = cb * 256 + cc; if (kq == 0) s += F.b_ada[l * 12288 + n];
            F.MODP[(size_t)kq * MODP_STRIDE + ((size_t)(l * 3 + g)) * 12288 + n] = s; }
        __syncthreads();
    }
    if (b == G - 1) {
        for (int i = tid; i < 2048; i += 512) { const int d = i >> 10, j = i & 1023; float v[4], m = -1e30f;
#pragma unroll
            for (int l = 0; l < 4; ++l) { v[l] = F.lower_bounds[(d * 4 + l) * 1024 + j]; m = fmaxf(m, v[l]); }
            float s = 0.f;
#pragma unroll
            for (int l = 0; l < 4; ++l) { v[l] = __expf(v[l] - m); s += v[l]; }
            const float inv = 1.f / s; float cum = 0.f; const float p0 = v[0] * inv;
#pragma unroll
            for (int l = 0; l < 4; ++l) { cum += v[l] * inv; F.LB[(d * 4 + l) * 1024 + j] = cum - p0; } }
    }
    constexpr int T_WIN = 4 * 3072, T_WOUT = 4 * 1024, T_WQ = 4 * 1024, T_WPOOL = 256, T_ALL = T_WIN + T_WOUT + T_WQ + T_WPOOL;
    for (int t = b; t < T_ALL; t += G) {
        const float* src; bf16_t* dst; int lsrc, ldst; bool plain = false;
        if (t < T_WIN) { const int l = t / 3072, r = t % 3072, kt = r / 96, nt = r % 96;
            src = F.w_in + (size_t)l * 2048 * 6144 + (size_t)(kt * 64) * 6144 + nt * 64; lsrc = 6144;
            if (nt < 80) { dst = F.WIN + (size_t)l * 6144 * 2048 + (size_t)(nt * 64) * 2048 + kt * 64; ldst = 2048; }
            else { const int n = nt * 64 - 5120, g = n >> 8, cc = n & 255; dst = F.WINU + ((size_t)(l * 4 + g) * 2048 + kt * 64) * 256 + cc; ldst = 256; plain = true; } }
        else if (t < T_WIN + T_WOUT + T_WQ) { const bool isq = t >= T_WIN + T_WOUT; const int tt = t - T_WIN - (isq ? T_WOUT : 0), l = tt >> 10, kt = (tt & 1023) >> 5, nt = tt & 31;
            src = (isq ? F.w_query : F.w_out) + (size_t)l * 2048 * 2048 + (size_t)(kt * 64) * 2048 + nt * 64; lsrc = 2048;
            dst = (isq ? F.WQ : F.WOUT) + (size_t)l * 2048 * 2048 + (size_t)(nt * 64) * 2048 + kt * 64; ldst = 2048; }
        else { const int tt = t - T_WIN - T_WOUT - T_WQ, mtx = tt >> 4, ct = (tt & 15) >> 2, dt = tt & 3;
            src = F.w_pool + (size_t)mtx * 65536 + (size_t)(ct * 64) * 256 + dt * 64; lsrc = 256;
            dst = F.WPOOL + (size_t)mtx * 65536 + (size_t)(dt * 64) * 256 + ct * 64; ldst = 256; }
        const int r = tid >> 4, c4 = (tid & 15) * 4;
        const f32x4 v0 = *(const f32x4*)(src + (size_t)r * lsrc + c4), v1 = *(const f32x4*)(src + (size_t)(r + 32) * lsrc + c4);
        if (plain) {
            u32x2 o0 = {pk_bf16(v0[0], v0[1]), pk_bf16(v0[2], v0[3])}, o1 = {pk_bf16(v1[0], v1[1]), pk_bf16(v1[2], v1[3])};
            *(u32x2*)(dst + (size_t)r * ldst + c4) = o0; *(u32x2*)(dst + (size_t)(r + 32) * ldst + c4) = o1;
        } else {
#pragma unroll
            for (int j = 0; j < 4; ++j) { tile[r * 65 + c4 + j] = v0[j]; tile[(r + 32) * 65 + c4 + j] = v1[j]; }
            __syncthreads();
            const int n = tid >> 3, kk = (tid & 7) * 8; float f[8];
#pragma unroll
            for (int j = 0; j < 8; ++j) f[j] = tile[(kk + j) * 65 + n];
            u32x4 o = {pk_bf16(f[0], f[1]), pk_bf16(f[2], f[3]), pk_bf16(f[4], f[5]), pk_bf16(f[6], f[7])};
            *(u32x4*)(dst + (size_t)n * ldst + kk) = o;
            __syncthreads();
        }
    }
    const size_t k8 = (size_t)4 * 8 * 2 * 128 * 128 / 8;
    for (size_t i = (size_t)b * 512 + tid; i < k8; i += (size_t)G * 512) {
        const f32x4* s = (const f32x4*)F.sub_keys + 2 * i; const f32x4 a = s[0], cc = s[1];
        u32x4 o = {pk_bf16(a[0], a[1]), pk_bf16(a[2], a[3]), pk_bf16(cc[0], cc[1]), pk_bf16(cc[2], cc[3])}; ((u32x4*)F.KEYS)[i] = o; }
}

DI void conv_tables(const Frame& F, const int l) {
    const int tid = fresh_tid(F.wave), lane = tid & 63, wave = __builtin_amdgcn_readfirstlane(tid >> 6), b = blockIdx.x, G = gridDim.x;
    for (int row = l * 16384 + b * 8 + wave; row < (l + 1) * 16384; row += G * 8) {
#pragma unroll
        for (int tb = 0; tb < 2; ++tb) {
            const float* src = (tb ? F.expert_v : F.expert_u) + (size_t)row * D + (lane >> 5) * 1024 + (lane & 31) * 4;
            f32x4 v[8]; float m = 0.f;
#pragma unroll
            for (int k = 0; k < 8; ++k) v[k] = __builtin_nontemporal_load((const f32x4*)(src + k * 128));
#pragma unroll
            for (int k = 0; k < 8; ++k) m = fmaxf(fmaxf(m, fmaxf(fabsf(v[k][0]), fabsf(v[k][1]))), fmaxf(fabsf(v[k][2]), fabsf(v[k][3])));
            float sc = m > 0.f ? m * (tb == 0 ? (1.0f / 7.0f) : (1.0f / 6.0f)) : 1.0f;
            const unsigned scb = (__float_as_uint(sc) + 0xffffu) >> 16; sc = __uint_as_float(scb << 16);
            const float inv = 1.0f / sc;
            unsigned pw[4];
            if (tb == 0) {
#pragma unroll
                for (int dd = 0; dd < 4; ++dd) { unsigned p = 0u;
#pragma unroll
                    for (int n = 0; n < 8; ++n) { const float xq = ((n < 4) ? v[2 * dd][n & 3] : v[2 * dd + 1][n & 3]) * inv; int q = (int)rintf(xq); q = q < -8 ? -8 : (q > 7 ? 7 : q); p |= (unsigned)(q & 15) << (4 * n); }
                    pw[dd] = p; }
            } else {
#pragma unroll
            for (int dd = 0; dd < 4; ++dd) { unsigned p = 0u;
                p = __builtin_amdgcn_cvt_scalef32_pk_fp4_f32(p, v[2 * dd][0] * inv, v[2 * dd][1] * inv, 1.0f, 0);
                p = __builtin_amdgcn_cvt_scalef32_pk_fp4_f32(p, v[2 * dd][2] * inv, v[2 * dd][3] * inv, 1.0f, 1);
                p = __builtin_amdgcn_cvt_scalef32_pk_fp4_f32(p, v[2 * dd + 1][0] * inv, v[2 * dd + 1][1] * inv, 1.0f, 2);
                p = __builtin_amdgcn_cvt_scalef32_pk_fp4_f32(p, v[2 * dd + 1][2] * inv, v[2 * dd + 1][3] * inv, 1.0f, 3);
                pw[dd] = p; }
            }
            unsigned char* dst = (tb ? F.VTAB : F.UTAB) + (size_t)row * ROWB;
            *(u32x4*)(dst + (lane & 31) * 32 + (lane >> 5) * 16) = (u32x4){pw[0], pw[1], pw[2], pw[3]};
            *(unsigned short*)(dst + 1024 + (lane & 31) * 4 + (lane >> 5) * 2) = (unsigned short)scb;
        }
    }
}

template <int NPART, bool XB> DI void norm_rows(const Frame& F, const void* xpv, const void* xsv, const float* nw, const float* modl, int sh_off, int sc_off) {
    const int tid = fresh_tid(F.wave), lane = tid & 63, wave = __builtin_amdgcn_readfirstlane(tid >> 6);
    for (int row = blockIdx.x * 8 + wave; row < NTOK; row += gridDim.x * 8) {
        const float* x = (row < TP) ? (const float*)xpv + (size_t)row * D : (const float*)xsv + (size_t)(row - TP) * D;
        const bf16_t* xb = (row < TP) ? (const bf16_t*)xpv + (size_t)row * D : (const bf16_t*)xsv + (size_t)(row - TP) * D;
        const int grp = (row < TP) ? 0 : 1 + ((row - TP) >> 11);
        const float* md = modl + (size_t)grp * 12288;
        f32x4 v[8]; float ss = 0.f;
#pragma unroll
        for (int j = 0; j < 8; ++j) { if (XB) { const u32x2 w = *(const u32x2*)(xb + j * 256 + lane * 4); v[j] = (f32x4){bf_lo(w.x), bf_hi(w.x), bf_lo(w.y), bf_hi(w.y)}; } else v[j] = *(const f32x4*)(x + j * 256 + lane * 4); ss += v[j][0] * v[j][0] + v[j][1] * v[j][1] + v[j][2] * v[j][2] + v[j][3] * v[j][3]; }
        ss = wave_sum(ss);
        const float rstd = __frsqrt_rn(ss * (1.0f / 2048.0f) + EPS);
#pragma unroll
        for (int j = 0; j < 8; ++j) { const int cidx = j * 256 + lane * 4;
            const f32x4 w = *(const f32x4*)(nw + cidx); f32x4 sc = *(const f32x4*)(md + sc_off + cidx), sh = *(const f32x4*)(md + sh_off + cidx);
#pragma unroll
            for (int p = 1; p < NPART; ++p) { sc += *(const f32x4*)(md + p * MODP_STRIDE + sc_off + cidx); sh += *(const f32x4*)(md + p * MODP_STRIDE + sh_off + cidx); }
            const f32x4 h = v[j] * rstd * w * (1.0f + sc) + sh;
            u32x2 o = {pk_bf16(h[0], h[1]), pk_bf16(h[2], h[3])};
            *(u32x2*)(F.HB + (size_t)row * D + cidx) = o; }
    }
}

constexpr int SC_QT = 0, SC_KH = 8704, SC_KT = 17408, SC_VT = 27648, SC_EB = 37888, SC_BUF = 38400;
DI bf16x8 pack8(const f32x16& x, const int s) {
    u32x4 p = {pk_bf16(x[8 * s], x[8 * s + 1]), pk_bf16(x[8 * s + 2], x[8 * s + 3]), pk_bf16(x[8 * s + 4], x[8 * s + 5]), pk_bf16(x[8 * s + 6], x[8 * s + 7])};
    return __builtin_bit_cast(bf16x8, p);
}
DI bf16x8 lds_2x8(const LAS unsigned char* p) {
    const u32x2 a = *(const LAS u32x2*)p, b = *(const LAS u32x2*)(p + 16);
    u32x4 r = {a[0], a[1], b[0], b[1]}; return __builtin_bit_cast(bf16x8, r);
}
DI void p3_scan(const Frame& F, const int l) {
    const int b = blockIdx.x; if (b >= 256) return;
    int tok0, T, bseq, h, cbeg; bool sample;
    if (b < 128) { sample = false; bseq = b >> 3; h = b & 7; T = 256; tok0 = bseq * 256; cbeg = 0; }
    else { sample = true; const int ix = b - 128; bseq = ix >> 6; cbeg = ((ix >> 3) & 7) * 8; h = ix & 7; T = 2048; tok0 = TP + bseq * 2048; }
    const int tid = fresh_tid(F.wave), lane = tid & 63, wave = __builtin_amdgcn_readfirstlane(tid >> 6);
    const int dir = wave >> 2, wv = wave & 3, r = lane & 31, hh = lane >> 5;
    LAS unsigned char* gbase = F.lds + dir * (2 * SC_BUF);
    const int cp = lane & 15, tg = lane >> 4, ch0 = 32 * wv + 2 * cp;
    const float lb0 = F.LB[(dir * 4 + l) * 1024 + h * 128 + ch0], lb1 = F.LB[(dir * 4 + l) * 1024 + h * 128 + ch0 + 1];
    const float om0 = 1.f - lb0, om1 = 1.f - lb1;
    const bf16_t* pcol = F.P + h * 128 + ch0;
    const int zoff = 1024 * (1 + dir);
    float* obuf = (dir ? F.OB : F.OF) + h * 128 + 32 * wv + r;
    f32x16 S[4];
#pragma unroll
    for (int mb = 0; mb < 4; ++mb)
#pragma unroll
        for (int i = 0; i < 16; ++i) S[mb][i] = 0.f;
    float bprev0 = 0.f, bprev1 = 0.f;
    unsigned qq[8], zz[8], vv[8], qn[8], zn[8], vn[8];
#pragma unroll
    for (int j = 0; j < 8; ++j) { int pos = cbeg * 32 + 8 * tg + j; if (dir) pos = T - 1 - pos; const bf16_t* rowp = pcol + (size_t)(tok0 + pos) * DIN;
        qq[j] = *(const unsigned*)rowp; zz[j] = *(const unsigned*)(rowp + zoff); vv[j] = *(const unsigned*)(rowp + 3072); }
#pragma unroll
    for (int j = 0; j < 8; ++j) { int pos = (cbeg + 1) * 32 + 8 * tg + j; if (dir) pos = T - 1 - pos; const bf16_t* rowp = pcol + (size_t)(tok0 + pos) * DIN;
        qn[j] = *(const unsigned*)rowp; zn[j] = *(const unsigned*)(rowp + zoff); vn[j] = *(const unsigned*)(rowp + 3072); }
    const float scale = 0.08838834764831845f;
    for (int c = cbeg; c < cbeg + 8; ++c) {
        LAS unsigned char* buf = gbase + (c & 1) * SC_BUF;
        {
            float bc0[8], bc1[8], k0[8], k1[8]; float run0 = 0.f, run1 = 0.f;
#pragma unroll
            for (int j = 0; j < 8; ++j) {
                const float z0 = fmaxf(bf_lo(zz[j]), -80.f), z1 = fmaxf(bf_hi(zz[j]), -80.f);
                const float e0 = __expf(-z0), e1 = __expf(-z1);
                const float s0 = __builtin_amdgcn_rcpf(1.f + e0), s1 = __builtin_amdgcn_rcpf(1.f + e1);
                const float f0 = lb0 + om0 * s0, f1 = lb1 + om1 * s1;
                k0[j] = om0 * e0 * s0; k1[j] = om1 * e1 * s1;
                run0 += __logf(f0); run1 += __logf(f1); bc0[j] = run0; bc1[j] = run1;
            }
#define LANE_GET(v, ln) __int_as_float(__builtin_amdgcn_ds_bpermute((ln) << 2, __float_as_int(v)))
            const float a00 = LANE_GET(run0, cp), a01 = LANE_GET(run0, cp + 16), a02 = LANE_GET(run0, cp + 32), a03 = LANE_GET(run0, cp + 48);
            const float a10 = LANE_GET(run1, cp), a11 = LANE_GET(run1, cp + 16), a12 = LANE_GET(run1, cp + 32), a13 = LANE_GET(run1, cp + 48);
#undef LANE_GET
            const float off0 = (tg > 0 ? a00 : 0.f) + (tg > 1 ? a01 : 0.f) + (tg > 2 ? a02 : 0.f);
            const float off1 = (tg > 0 ? a10 : 0.f) + (tg > 1 ? a11 : 0.f) + (tg > 2 ? a12 : 0.f);
            unsigned kt0[4], kt1[4], vt0[4], vt1[4]; float kh0[8], kh1[8];
            const float ep0 = __expf(bprev0), ep1 = __expf(bprev1);
#pragma unroll
            for (int j = 0; j < 8; ++j) {
                const float B0 = off0 + bc0[j], B1 = off1 + bc1[j];
                const float eq0 = __expf(B0), eq1 = __expf(B1), ek0 = __expf(fminf(-B0, 85.f)), ek1 = __expf(fminf(-B1, 85.f));
                const float qt0 = bf_lo(qq[j]) * eq0, qt1 = bf_hi(qq[j]) * eq1;
                kh0[j] = k0[j] * ek0; kh1[j] = k1[j] * ek1;
                const int rr = 8 * tg + j;
                *(LAS unsigned*)(buf + SC_QT + rr * 272 + ch0 * 2) = pk_bf16(qt0, qt1);
                *(LAS unsigned*)(buf + SC_KH + rr * 272 + ch0 * 2) = pk_bf16(kh0[j], kh1[j]);
                if (sample) { int pos = c * 32 + rr; if (dir) pos = T - 1 - pos;
                    *(unsigned*)(F.QH + ((size_t)dir * 4096 + bseq * 2048 + pos) * 1024 + h * 128 + ch0) = pk_bf16(qt0 * ep0, qt1 * ep1); }
            }
#pragma unroll
            for (int j = 0; j < 4; ++j) { kt0[j] = pk_bf16(kh0[2 * j], kh0[2 * j + 1]); kt1[j] = pk_bf16(kh1[2 * j], kh1[2 * j + 1]);
                vt0[j] = (vv[2 * j] & 0xffffu) | (vv[2 * j + 1] << 16); vt1[j] = (vv[2 * j] >> 16) | (vv[2 * j + 1] & 0xffff0000u); }
            *(LAS u32x4*)(buf + SC_KT + ch0 * 80 + 16 * tg) = (u32x4){kt0[0], kt0[1], kt0[2], kt0[3]};
            *(LAS u32x4*)(buf + SC_KT + (ch0 + 1) * 80 + 16 * tg) = (u32x4){kt1[0], kt1[1], kt1[2], kt1[3]};
            *(LAS u32x4*)(buf + SC_VT + ch0 * 80 + 16 * tg) = (u32x4){vt0[0], vt0[1], vt0[2], vt0[3]};
            *(LAS u32x4*)(buf + SC_VT + (ch0 + 1) * 80 + 16 * tg) = (u32x4){vt1[0], vt1[1], vt1[2], vt1[3]};
            const float t0 = a00 + a01 + a02 + a03, t1 = a10 + a11 + a12 + a13; bprev0 += t0; bprev1 += t1;
            if (tg == 0) *(LAS f32x2*)(buf + SC_EB + ch0 * 4) = (f32x2){__expf(t0), __expf(t1)};
        }
#pragma unroll
        for (int j = 0; j < 8; ++j) { qq[j] = qn[j]; zz[j] = zn[j]; vv[j] = vn[j]; }
        if (c + 2 < cbeg + 8) {
#pragma unroll
            for (int j = 0; j < 8; ++j) { int pos = (c + 2) * 32 + 8 * tg + j; if (dir) pos = T - 1 - pos; const bf16_t* rowp = pcol + (size_t)(tok0 + pos) * DIN;
                qn[j] = *(const unsigned*)rowp; zn[j] = *(const unsigned*)(rowp + zoff); vn[j] = *(const unsigned*)(rowp + 3072); }
        }
        __syncthreads();
        f32x16 Pm;
#pragma unroll
        for (int i = 0; i < 16; ++i) Pm[i] = 0.f;
#pragma unroll
        for (int ks = 0; ks < 8; ++ks) {
            const bf16x8 a = *(const LAS bf16x8*)(buf + SC_KH + r * 272 + (16 * ks + 8 * hh) * 2);
            const bf16x8 bq = *(const LAS bf16x8*)(buf + SC_QT + r * 272 + (16 * ks + 8 * hh) * 2);
            Pm = MFMA32(a, bq, Pm);
        }
#pragma unroll
        for (int i = 0; i < 16; ++i) Pm[i] = (crow(i, hh) <= r) ? Pm[i] : 0.f;
        f32x16 O;
#pragma unroll
        for (int i = 0; i < 16; ++i) O[i] = 0.f;
#pragma unroll
        for (int mb = 0; mb < 4; ++mb)
#pragma unroll
            for (int s2 = 0; s2 < 2; ++s2) {
                const bf16x8 a = lds_2x8(buf + SC_QT + r * 272 + (32 * mb + 16 * s2 + 4 * hh) * 2);
                O = MFMA32(a, pack8(S[mb], s2), O);
            }
#pragma unroll
        for (int s2 = 0; s2 < 2; ++s2) {
            const bf16x8 bv = lds_2x8(buf + SC_VT + (32 * wv + r) * 80 + (16 * s2 + 4 * hh) * 2);
            O = MFMA32(pack8(Pm, s2), bv, O);
        }
#pragma unroll
        for (int mb = 0; mb < 4; ++mb) {
#pragma unroll
            for (int ks = 0; ks < 2; ++ks) {
                const bf16x8 a = *(const LAS bf16x8*)(buf + SC_KT + (32 * mb + r) * 80 + (16 * ks + 8 * hh) * 2);
                const bf16x8 bv = *(const LAS bf16x8*)(buf + SC_VT + (32 * wv + r) * 80 + (16 * ks + 8 * hh) * 2);
                S[mb] = MFMA32(a, bv, S[mb]);
            }
#pragma unroll
            for (int q4 = 0; q4 < 4; ++q4) { const f32x4 e = *(const LAS f32x4*)(buf + SC_EB + (32 * mb + 8 * q4 + 4 * hh) * 4);
#pragma unroll
                for (int j = 0; j < 4; ++j) S[mb][4 * q4 + j] *= e[j]; }
        }
#pragma unroll
        for (int i = 0; i < 16; ++i) { int pos = c * 32 + crow(i, hh); if (dir) pos = T - 1 - pos; obuf[(size_t)(tok0 + pos) * 1024] = O[i] * scale; }
    }
    float* so;
    if (!sample) so = F.out + (size_t)NTOK * D + ((size_t)((bseq * 4 + l) * 2 + dir) * 8 + h) * 16384 + 32 * wv + r;
    else { const int u = ((bseq * 2 + dir) * 8 + h) * 8 + (cbeg >> 3); so = F.SSEG + (size_t)u * 16384 + 32 * wv + r;
        if (tg == 0) *(f32x2*)(F.DSEG + (size_t)u * 128 + ch0) = (f32x2){__expf(bprev0), __expf(bprev1)}; }
#pragma unroll
    for (int mb = 0; mb < 4; ++mb)
#pragma unroll
        for (int i = 0; i < 16; ++i) so[(32 * mb + crow(i, hh)) * 128] = S[mb][i];
}

DI void p3c_correct(const Frame& F, const int l) {
    const int u = blockIdx.x; if (u >= 256) return;
    const int tid = fresh_tid(F.wave), lane = tid & 63, wave = __builtin_amdgcn_readfirstlane(tid >> 6), r = lane & 31, hh = lane >> 5;
    const int sseq = u >> 7, dir = (u >> 6) & 1, h = (u >> 3) & 7, seg = u & 7, ub = u - seg;
    {
        const int v = tid & 127, kq = tid >> 7;
        const float* st0 = F.state_in + ((size_t)((sseq * 4 + l) * 2 + dir) * 8 + h) * 16384 + v;
        float val[32];
#pragma unroll
        for (int kk = 0; kk < 32; ++kk) val[kk] = st0[(kq * 32 + kk) * 128];
        for (int j = 0; j < seg; ++j) { const float* sp = F.SSEG + (size_t)(ub + j) * 16384 + v; const float* dp = F.DSEG + (size_t)(ub + j) * 128;
#pragma unroll
            for (int kk = 0; kk < 32; ++kk) val[kk] = dp[kq * 32 + kk] * val[kk] + sp[(kq * 32 + kk) * 128]; }
#pragma unroll
        for (int g = 0; g < 4; ++g)
            *(LAS u32x4*)(F.lds + v * 272 + (kq * 32 + 8 * g) * 2) = (u32x4){pk_bf16(val[8 * g], val[8 * g + 1]), pk_bf16(val[8 * g + 2], val[8 * g + 3]), pk_bf16(val[8 * g + 4], val[8 * g + 5]), pk_bf16(val[8 * g + 6], val[8 * g + 7])};
    }
    __syncthreads();
    int posr = seg * 256 + 32 * wave + r; if (dir) posr = 2047 - posr;
    const bf16_t* qp = F.QH + ((size_t)dir * 4096 + sseq * 2048 + posr) * 1024 + h * 128 + 8 * hh;
    bf16x8 a[8];
#pragma unroll
    for (int ks = 0; ks < 8; ++ks) a[ks] = *(const bf16x8*)(qp + 16 * ks);
    float* ob = (dir ? F.OB : F.OF) + (size_t)(TP + sseq * 2048) * 1024 + h * 128 + r;
    const float scale = 0.08838834764831845f;
#pragma unroll
    for (int nb = 0; nb < 4; ++nb) {
        f32x16 acc;
#pragma unroll
        for (int i = 0; i < 16; ++i) acc[i] = 0.f;
#pragma unroll
        for (int ks = 0; ks < 8; ++ks) { const bf16x8 bv = *(const LAS bf16x8*)(F.lds + (32 * nb + r) * 272 + (16 * ks + 8 * hh) * 2); acc = MFMA32(a[ks], bv, acc); }
#pragma unroll
        for (int i = 0; i < 16; ++i) { int pos = seg * 256 + 32 * wave + crow(i, hh); if (dir) pos = 2047 - pos; float* op = ob + (size_t)pos * 1024 + 32 * nb; *op += scale * acc[i]; }
    }
}

DI void p4_combine(const Frame& F, const int l) {
    const int tid = fresh_tid(F.wave), lane = tid & 63, wave = __builtin_amdgcn_readfirstlane(tid >> 6), c0 = lane * 16;
    for (int tok = blockIdx.x * 8 + wave; tok < NTOK; tok += gridDim.x * 8) {
        {
            const float* pf = F.OF + (size_t)tok * 1024 + c0; const float* pb = F.OB + (size_t)tok * 1024 + c0;
            f32x4 o[4]; float ss = 0.f;
#pragma unroll
            for (int j = 0; j < 4; ++j) { o[j] = *(const f32x4*)(pf + 4 * j) + *(const f32x4*)(pb + 4 * j); ss += o[j][0] * o[j][0] + o[j][1] * o[j][1] + o[j][2] * o[j][2] + o[j][3] * o[j][3]; }
            ss += xshfl<1>(ss); ss += xshfl<2>(ss); ss += xshfl<4>(ss);
            const float rstd = __frsqrt_rn(ss * (1.0f / 128.0f) + EPS);
            const u32x4 g0 = *(const u32x4*)(F.P + (size_t)tok * DIN + 4096 + c0), g1 = *(const u32x4*)(F.P + (size_t)tok * DIN + 4096 + c0 + 8);
            const float* gw = F.hgrn_norm_w + l * 1024 + c0;
            unsigned w[8];
#pragma unroll
            for (int j = 0; j < 4; ++j) { const f32x4 gn = *(const f32x4*)(gw + 4 * j); const unsigned ga = (j < 2) ? g0[2 * j] : g1[2 * j - 4], gb = (j < 2) ? g0[2 * j + 1] : g1[2 * j - 3];
                const float r0 = o[j][0] * rstd * gn[0] * silu_f(bf_lo(ga)), r1 = o[j][1] * rstd * gn[1] * silu_f(bf_hi(ga));
                const float r2 = o[j][2] * rstd * gn[2] * silu_f(bf_lo(gb)), r3 = o[j][3] * rstd * gn[3] * silu_f(bf_hi(gb));
                w[2 * j] = pk_bf16(r0, r1); w[2 * j + 1] = pk_bf16(r2, r3); }
            bf16_t* dst = F.CAT + (size_t)tok * D + c0;
            *(u32x4*)dst = (u32x4){w[0], w[1], w[2], w[3]}; *(u32x4*)(dst + 8) = (u32x4){w[4], w[5], w[6], w[7]};
        }
        {
            const int gi = lane >> 4, half = 1 << gi;
            int L, pos; if (tok < TP) { L = 256; pos = tok & 255; } else { L = 64; pos = (tok - TP) & 63; }
            const int sbase = tok - pos; int lo = pos - half; lo = lo < 0 ? 0 : lo; int hi = pos + half; hi = hi > L ? L : hi;
            float acc[16];
#pragma unroll
            for (int j = 0; j < 16; ++j) acc[j] = 0.f;
            const bf16_t* pu = F.P + 5120 + c0;
            for (int d0 = -half; d0 < half; d0 += 4) {
                u32x4 a[4], bq[4]; float mk[4];
#pragma unroll
                for (int u = 0; u < 4; ++u) { const int d = d0 + u, t = pos + d; const bool ok = (d < half) && (t >= 0) && (t < L); const int tt = ok ? t : pos; mk[u] = ok ? 1.f : 0.f;
                    a[u] = *(const u32x4*)(pu + (size_t)(sbase + tt) * DIN); bq[u] = *(const u32x4*)(pu + (size_t)(sbase + tt) * DIN + 8); }
#pragma unroll
                for (int u = 0; u < 4; ++u)
#pragma unroll
                    for (int j = 0; j < 4; ++j) { acc[2 * j] += mk[u] * bf_lo(a[u][j]); acc[2 * j + 1] += mk[u] * bf_hi(a[u][j]); acc[8 + 2 * j] += mk[u] * bf_lo(bq[u][j]); acc[9 + 2 * j] += mk[u] * bf_hi(bq[u][j]); } }
            const float inv = 1.0f / (float)(hi - lo);
            const u32x4 sa = *(const u32x4*)(pu + (size_t)tok * DIN), sb = *(const u32x4*)(pu + (size_t)tok * DIN + 8);
            const float* ps = F.pool_scale + l * 1024 + c0;
            unsigned w[8];
#pragma unroll
            for (int j = 0; j < 4; ++j) { const f32x4 s0 = *(const f32x4*)(ps + 4 * j);
                const unsigned ua = (j < 2) ? sa[2 * j] : sb[2 * j - 4], ub = (j < 2) ? sa[2 * j + 1] : sb[2 * j - 3];
                const float r0 = (acc[4 * j] * inv - bf_lo(ua)) * s0[0], r1 = (acc[4 * j + 1] * inv - bf_hi(ua)) * s0[1];
                const float r2 = (acc[4 * j + 2] * inv - bf_lo(ub)) * s0[2], r3 = (acc[4 * j + 3] * inv - bf_hi(ub)) * s0[3];
                w[2 * j] = pk_bf16(r0, r1); w[2 * j + 1] = pk_bf16(r2, r3); }
            bf16_t* dst = F.CAT + (size_t)tok * D + 1024 + c0;
            *(u32x4*)dst = (u32x4){w[0], w[1], w[2], w[3]}; *(u32x4*)(dst + 8) = (u32x4){w[4], w[5], w[6], w[7]};
        }
    }
}

#define CE_D(a, b) do { const float _h = fmaxf(a, b), _l = fminf(a, b); a = _h; b = _l; } while (0)
#define CE_A(a, b) do { const float _h = fmaxf(a, b), _l = fminf(a, b); a = _l; b = _h; } while (0)
template <int N> DI void bitonic_sort_desc(float* v) {
#pragma unroll
    for (int k = 2; k <= N; k <<= 1)
#pragma unroll
        for (int j = k >> 1; j > 0; j >>= 1)
#pragma unroll
            for (int i = 0; i < N; ++i) { const int x = i ^ j; if (x > i) { if ((i & k) == 0) CE_D(v[i], v[x]); else CE_A(v[i], v[x]); } }
}
template <int N> DI void bitonic_merge_desc(float* v) {
#pragma unroll
    for (int j = N >> 1; j > 0; j >>= 1)
#pragma unroll
        for (int i = 0; i < N; ++i) { const int x = i ^ j; if (x > i) CE_D(v[i], v[x]); }
}
#define CEP_D(ka, kb, pa, pb) do { const bool _s = (kb) > (ka); const float _k = _s ? (kb) : (ka); kb = _s ? (ka) : (kb); ka = _k; const unsigned _p = _s ? (pb) : (pa); pb = _s ? (pa) : (pb); pa = _p; } while (0)
#define CEP_A(ka, kb, pa, pb) do { const bool _s = (kb) < (ka); const float _k = _s ? (kb) : (ka); kb = _s ? (ka) : (kb); ka = _k; const unsigned _p = _s ? (pb) : (pa); pb = _s ? (pa) : (pb); pa = _p; } while (0)
template <int N> DI void bitonic_sort_desc_p(float* v, unsigned* p) {
#pragma unroll
    for (int k = 2; k <= N; k <<= 1)
#pragma unroll
        for (int j = k >> 1; j > 0; j >>= 1)
#pragma unroll
            for (int i = 0; i < N; ++i) { const int x = i ^ j; if (x > i) { if ((i & k) == 0) CEP_D(v[i], v[x], p[i], p[x]); else CEP_A(v[i], v[x], p[i], p[x]); } }
}
template <int N> DI void bitonic_merge_desc_p(float* v, unsigned* p) {
#pragma unroll
    for (int j = N >> 1; j > 0; j >>= 1)
#pragma unroll
        for (int i = 0; i < N; ++i) { const int x = i ^ j; if (x > i) CEP_D(v[i], v[x], p[i], p[x]); }
}
DI void p8_topk(const Frame& F, const int l, const pg8::StaticOrder& S) {
    const int tid = fresh_tid(F.wave), lane = tid & 63, wave = __builtin_amdgcn_readfirstlane(tid >> 6), r = lane & 31, hh = lane >> 5;
    pg8::Unit u;
    for (int ui = 0; S.next(ui, u); ++ui) {
        const int tile = u.pm * 8 + wave, h = u.pn; const int tok = tile * 32 + r;
        float s1[16], s2[16];
#pragma unroll 1
        for (int p = 0; p < 2; ++p) {
            const bf16_t* qrow = F.Q + (size_t)tok * D + h * 256 + p * 128 + 8 * hh;
            bf16x8 bq[8];
#pragma unroll
            for (int ks = 0; ks < 8; ++ks) bq[ks] = *(const bf16x8*)(qrow + 16 * ks);
            const bf16_t* kb = F.KEYS + ((size_t)((l * 8 + h) * 2 + p) * 128) * 128 + 8 * hh;
            float best[16];
#pragma unroll
            for (int i = 0; i < 16; ++i) best[i] = -INFINITY;
#pragma unroll 1
            for (int mb = 0; mb < 4; ++mb) {
                f32x16 acc;
#pragma unroll
                for (int i = 0; i < 16; ++i) acc[i] = 0.f;
#pragma unroll
                for (int ks = 0; ks < 8; ++ks) { const bf16x8 a = *(const bf16x8*)(kb + (size_t)(32 * mb + r) * 128 + 16 * ks); acc = MFMA32(a, bq[ks], acc); }
                float sc[16];
#pragma unroll
                for (int i = 0; i < 16; ++i) sc[i] = __uint_as_float((__float_as_uint(acc[i]) & ~127u) | (unsigned)(32 * mb + crow(i, hh)));
                bitonic_sort_desc<16>(sc);
#pragma unroll
                for (int i = 0; i < 16; ++i) best[i] = fmaxf(best[i], sc[15 - i]);
                bitonic_merge_desc<16>(best);
            }
            float pbv[16];
#pragma unroll
            for (int i = 0; i < 16; ++i) pbv[i] = xshfl<32>(best[i]);
#pragma unroll
            for (int i = 0; i < 16; ++i) best[i] = fmaxf(best[i], pbv[15 - i]);
            bitonic_merge_desc<16>(best);
            if (p == 0) {
#pragma unroll
                for (int i = 0; i < 16; ++i) s1[i] = best[i];
            } else {
#pragma unroll
                for (int i = 0; i < 16; ++i) s2[i] = best[i];
            }
        }
        float ca[16], cb[16]; unsigned ia[16], ib[16];
        const unsigned sha = hh ? 0u : 7u, shb = hh ? 7u : 0u;
#pragma unroll
        for (int i = 0; i < 16; ++i) { ca[i] = hh ? s2[i] : s1[i]; cb[i] = hh ? s1[i] : s2[i];
            ia[i] = (__float_as_uint(ca[i]) & 127u) << sha; ib[i] = (__float_as_uint(cb[i]) & 127u) << shb; }
        float cs[32]; unsigned cid[32];
        {
            int n = 0;
#pragma unroll
            for (int i = 0; i < 4; ++i)
#pragma unroll
                for (int j = i; j < 16; ++j) if ((i + 1) * (j + 1) <= 16) { float sv = ca[i] + cb[j]; if (i == j && hh) sv = -INFINITY; cs[n] = sv; cid[n] = ia[i] | ib[j]; ++n; }
#pragma unroll
            for (; n < 32; ++n) { cs[n] = -INFINITY; cid[n] = 0u; }
        }
        float tk[16]; unsigned ti[16];
#pragma unroll
        for (int i = 0; i < 16; ++i) { tk[i] = -INFINITY; ti[i] = 0u; }
#pragma unroll 1
        for (int it = 0; it < 2; ++it) {
            float ck[16]; unsigned ci[16];
#pragma unroll
            for (int i = 0; i < 16; ++i) { ck[i] = it ? cs[16 + i] : cs[i]; ci[i] = it ? cid[16 + i] : cid[i]; }
            bitonic_sort_desc_p<16>(ck, ci);
#pragma unroll
            for (int i = 0; i < 16; ++i) { const bool sw = ck[15 - i] > tk[i]; tk[i] = sw ? ck[15 - i] : tk[i]; ti[i] = sw ? ci[15 - i] : ti[i]; }
            bitonic_merge_desc_p<16>(tk, ti);
        }
        float pk_[16]; unsigned pi_[16];
#pragma unroll
        for (int i = 0; i < 16; ++i) { pk_[i] = xshfl<32>(tk[i]); pi_[i] = __float_as_uint(xshfl<32>(__uint_as_float(ti[i]))); }
        float fk[16]; unsigned fi[16]; float mx = -INFINITY;
#pragma unroll
        for (int i = 0; i < 16; ++i) { const bool sw = pk_[15 - i] > tk[i]; fk[i] = sw ? pk_[15 - i] : tk[i]; fi[i] = sw ? pi_[15 - i] : ti[i]; mx = fmaxf(mx, fk[i]); }
        float z = 0.f;
#pragma unroll
        for (int i = 0; i < 16; ++i) { fk[i] = __expf(fk[i] - mx); z += fk[i]; }
        const float iz = 1.0f / z;
        int* di = F.SELI + (size_t)tok * 128 + h * 16 + hh * 8; float* dg = F.SELG + (size_t)tok * 128 + h * 16 + hh * 8;
        *(u32x4*)di = (u32x4){fi[0], fi[1], fi[2], fi[3]}; *(u32x4*)(di + 4) = (u32x4){fi[4], fi[5], fi[6], fi[7]};
        *(f32x4*)dg = (f32x4){fk[0] * iz, fk[1] * iz, fk[2] * iz, fk[3] * iz}; *(f32x4*)(dg + 4) = (f32x4){fk[4] * iz, fk[5] * iz, fk[6] * iz, fk[7] * iz};
    }
}

constexpr int NB = 4;
DI float reduce8(const float (&p)[8], const int lane) {
    const bool b5 = lane & 32, b4 = lane & 16, b3 = lane & 8;
    float k4[4], k2[2];
#pragma unroll
    for (int i = 0; i < 4; ++i) { const float snd = b5 ? p[i] : p[i + 4], kp = b5 ? p[i + 4] : p[i]; k4[i] = kp + xshfl<32>(snd); }
#pragma unroll
    for (int i = 0; i < 2; ++i) { const float snd = b4 ? k4[i] : k4[i + 2], kp = b4 ? k4[i + 2] : k4[i]; k2[i] = kp + xshfl<16>(snd); }
    const float snd = b3 ? k2[0] : k2[1], kp = b3 ? k2[1] : k2[0];
    float t = kp + xshfl<8>(snd);
    t += xshfl<4>(t); t += xshfl<2>(t); t += xshfl<1>(t);
    return t;
}
#define CVT8(x, hi) __builtin_amdgcn_cvt_pk_f32_fp8((x), (hi))
constexpr int NT = 2;
DI float half_sum(float v) { v += xshfl<16>(v); v += xshfl<8>(v); v += xshfl<4>(v); v += xshfl<2>(v); v += xshfl<1>(v); return v; }
DI float half_max(float v) { v = fmaxf(v, xshfl<16>(v)); v = fmaxf(v, xshfl<8>(v)); v = fmaxf(v, xshfl<4>(v)); v = fmaxf(v, xshfl<2>(v)); v = fmaxf(v, xshfl<1>(v)); return v; }
DI float reduce8h(const float (&p)[8], const int lane) {
    const bool b4 = lane & 16, b3 = lane & 8, b2 = lane & 4;
    float k4[4], k2[2];
#pragma unroll
    for (int i = 0; i < 4; ++i) { const float snd = b4 ? p[i] : p[i + 4], kp = b4 ? p[i + 4] : p[i]; k4[i] = kp + xshfl<16>(snd); }
#pragma unroll
    for (int i = 0; i < 2; ++i) { const float snd = b3 ? k4[i] : k4[i + 2], kp = b3 ? k4[i + 2] : k4[i]; k2[i] = kp + xshfl<8>(snd); }
    const float snd = b2 ? k2[0] : k2[1], kp = b2 ? k2[1] : k2[0];
    float t = kp + xshfl<4>(snd);
    t += xshfl<2>(t); t += xshfl<1>(t);
    return t;
}
struct RowH { u32x4 d[2]; unsigned s; };
DI h32v blk_decode(const RowH& r, const int t) { h32v e;
#pragma unroll
    for (int dd = 0; dd < 4; ++dd)
        { const unsigned w = r.d[t][dd];
          const h2v v0 = __builtin_amdgcn_cvt_scalef32_pk_f16_fp4(w, 1.0f, 0), v1 = __builtin_amdgcn_cvt_scalef32_pk_f16_fp4(w, 1.0f, 1), v2 = __builtin_amdgcn_cvt_scalef32_pk_f16_fp4(w, 1.0f, 2), v3 = __builtin_amdgcn_cvt_scalef32_pk_f16_fp4(w, 1.0f, 3);
          e[8 * dd] = v0.x; e[8 * dd + 1] = v0.y; e[8 * dd + 2] = v1.x; e[8 * dd + 3] = v1.y; e[8 * dd + 4] = v2.x; e[8 * dd + 5] = v2.y; e[8 * dd + 6] = v3.x; e[8 * dd + 7] = v3.y; }
    return e; }
DI float blk_scale(const RowH& r, const int t) { return t ? __uint_as_float(r.s & 0xffff0000u) : __uint_as_float(r.s << 16); }
DI float dot64(const RowH& r, const h2v (&hv)[32]) {
    float tot = 0.f;
#pragma unroll
    for (int t = 0; t < 2; ++t) { const h32v e = blk_decode(r, t); float acc = 0.f;
#pragma unroll
        for (int p = 0; p < 16; ++p) acc = __builtin_amdgcn_fdot2((h2v){e[2 * p], e[2 * p + 1]}, hv[t * 16 + p], acc, false);
        tot += acc * blk_scale(r, t); }
    return tot;
}
DI float dot64i(const RowH& r, const int (&hh)[8], const int (&hl)[8], const float (&shs)[2]) {
    float tot = 0.f;
#pragma unroll
    for (int t = 0; t < 2; ++t) { int ah = 0, al = 0;
#pragma unroll
        for (int dd = 0; dd < 4; ++dd) { ah = __builtin_amdgcn_sdot8((int)r.d[t][dd], hh[t * 4 + dd], ah, false); al = __builtin_amdgcn_sdot8((int)r.d[t][dd], hl[t * 4 + dd], al, false); }
        tot += (float)(ah * 16 + al) * (blk_scale(r, t) * shs[t]); }
    return tot;
}
DI void axpy64(const RowH& r, h2v (&ov)[32], const float w) {
#pragma unroll
    for (int t = 0; t < 2; ++t) { const h32v e = blk_decode(r, t); const _Float16 ws = (_Float16)(w * blk_scale(r, t)); const h2v wv = {ws, ws};
#pragma unroll
        for (int p = 0; p < 16; ++p) ov[t * 16 + p] += (h2v){e[2 * p], e[2 * p + 1]} * wv; }
}
DI void p9_peer(const Frame& F, const int l) {
    const int tid = fresh_tid(F.wave), lane = tid & 63, wave = __builtin_amdgcn_readfirstlane(tid >> 6);
    const unsigned char* UTu = F.UTAB + (size_t)l * NEXP * ROWB; const unsigned char* VTu = F.VTAB + (size_t)l * NEXP * ROWB;
    for (int tokb = (blockIdx.x * 8 + wave) * NT; tokb < NTOK; tokb += gridDim.x * 8 * NT) {
        int lnn = lane; asm volatile("; addresses of this token pair are rebuilt here, not hoisted" : "+v"(lnn));
        const int half = lnn >> 5, lq = lnn & 31;
        LAS unsigned* listw = (LAS unsigned*)(F.lds + wave * 3072 + half * 512);
        LAS float* listg = (LAS float*)(F.lds + wave * 3072 + 1024 + half * 512);
        LAS float* actl = (LAS float*)(F.lds + wave * 3072 + 2048 + half * 512);
        const int tok = tokb + half;
        {
            LAS unsigned* keyl = (LAS unsigned*)actl;
            unsigned key[4]; float gg[4]; unsigned rk[4];
#pragma unroll
            for (int r = 0; r < 4; ++r) { const size_t ei = (size_t)tok * 128 + r * 32 + lq; key[r] = ((unsigned)F.SELI[ei] << 7) | (unsigned)(r * 32 + lq); gg[r] = F.SELG[ei]; keyl[r * 32 + lq] = key[r]; rk[r] = 0u; }
#pragma unroll 1
            for (int j = 0; j < 128; j += 4) { const u32x4 kk = *(const LAS u32x4*)(keyl + j);
#pragma unroll
                for (int q = 0; q < 4; ++q)
#pragma unroll
                    for (int r = 0; r < 4; ++r) rk[r] += (kk[q] < key[r]) ? 1u : 0u; }
#pragma unroll
            for (int r = 0; r < 4; ++r) { listw[rk[r]] = key[r] >> 7; listg[rk[r]] = gg[r]; }
        }
#define H_LOAD(buf, TABu, idv) do { const unsigned char* rp_ = TABu + (size_t)(idv) * ROWB; buf.d[0] = *(const u32x4*)(rp_ + lq * 32); buf.d[1] = *(const u32x4*)(rp_ + lq * 32 + 16); buf.s = *(const unsigned*)(rp_ + 1024 + lq * 4); } while (0)
#define H_LOAD4(buf, TABu, k) do { const u32x4 i4_ = *(const LAS u32x4*)(listw + (k)); H_LOAD(buf[0], TABu, i4_[0]); H_LOAD(buf[1], TABu, i4_[1]); H_LOAD(buf[2], TABu, i4_[2]); H_LOAD(buf[3], TABu, i4_[3]); } while (0)
        {
            RowH ra[4], rb[4];
            H_LOAD4(ra, UTu, 0);
            int hh[8], hl[8]; float shs[2];
#pragma unroll
            for (int t = 0; t < 2; ++t) {
                float hv[32]; float m = 0.f;
#pragma unroll
                for (int k = 0; k < 8; ++k) { const u32x2 a = *(const u32x2*)(F.HB + (size_t)tok * D + t * 1024 + k * 128 + lq * 4);
                    hv[4 * k] = bf_lo(a[0]); hv[4 * k + 1] = bf_hi(a[0]); hv[4 * k + 2] = bf_lo(a[1]); hv[4 * k + 3] = bf_hi(a[1]); }
#pragma unroll
                for (int i = 0; i < 32; ++i) m = fmaxf(m, fabsf(hv[i]));
                const float sh = m > 0.f ? m * (1.0f / 119.0f) : 1.0f, ih = 1.0f / sh; shs[t] = sh;
#pragma unroll
                for (int dd = 0; dd < 4; ++dd) { unsigned ph = 0u, pl = 0u;
#pragma unroll
                    for (int n = 0; n < 8; ++n) { const int q = (int)rintf(hv[8 * dd + n] * ih); const int lo = ((q + 8) & 15) - 8, hi = (q - lo) >> 4;
                        ph |= (unsigned)(hi & 15) << (4 * n); pl |= (unsigned)(lo & 15) << (4 * n); }
                    hh[t * 4 + dd] = (int)ph; hl[t * 4 + dd] = (int)pl; }
            }
#pragma unroll 1
            for (int k0 = 0; k0 < 128; k0 += 8) {
                float pp[8];
                H_LOAD4(rb, UTu, k0 + 4);
#pragma unroll
                for (int q = 0; q < 4; ++q) { pp[q] = dot64i(ra[q], hh, hl, shs); }
                if (k0 != 120) H_LOAD4(ra, UTu, k0 + 8);
#pragma unroll
                for (int q = 0; q < 4; ++q) { pp[4 + q] = dot64i(rb[q], hh, hl, shs); }
                { const float t = reduce8h(pp, lq); if ((lq & 3) == 0) actl[k0 + (((lq >> 4) & 1) * 4 + ((lq >> 3) & 1) * 2 + ((lq >> 2) & 1))] = t; }
            }
        }
        RowH va[4], vb[4];
        H_LOAD4(va, VTu, 0);
#pragma unroll
        for (int r = 0; r < 4; ++r) { const int pos = r * 32 + lq; const float act = actl[pos]; listg[pos] = listg[pos] * 0.5f * act * (1.0f + erff(act * 0.70710678118654752f)); }
        h2v o[32];
#pragma unroll
        for (int j = 0; j < 32; ++j) o[j] = (h2v){(_Float16)0.f, (_Float16)0.f};
        {
#define H_AXPY4(buf, k) do { const f32x4 w4_ = *(const LAS f32x4*)(listg + (k)); _Pragma("unroll") for (int q = 0; q < 4; ++q) { axpy64(buf[q], o, w4_[q]); __builtin_amdgcn_sched_barrier(0); } } while (0)
#pragma unroll 1
            for (int k0 = 0; k0 < 128; k0 += 8) {
                H_LOAD4(vb, VTu, k0 + 4);
                H_AXPY4(va, k0);
                if (k0 != 120) H_LOAD4(va, VTu, k0 + 8);
                H_AXPY4(vb, k0 + 4);
            }
        }
#undef H_LOAD4
#undef H_AXPY4
#undef H_LOAD
        {
            int le = lq; asm volatile("; epilogue addresses rebuilt per token" : "+v"(le));
            const int grp = (tok < TP) ? 0 : 1 + ((tok - TP) >> 11);
            const float* md = F.MOD + (size_t)(l * 3 + grp) * 12288;
            bf16_t* xr = F.XB + (size_t)tok * D + le * 4;
            f32x4 xn[16]; float ss = 0.f;
#pragma unroll
            for (int t = 0; t < 2; ++t)
#pragma unroll
                for (int k = 0; k < 8; ++k) { bf16_t* xp = xr + t * 1024 + k * 128;
                    const u32x2 xw = *(const u32x2*)xp; const f32x4 xa = {bf_lo(xw.x), bf_hi(xw.x), bf_lo(xw.y), bf_hi(xw.y)}, ga = *(const f32x4*)(md + 10240 + le * 4 + t * 1024 + k * 128);
                    const f32x4 ov = {(float)o[t * 16 + 2 * k].x, (float)o[t * 16 + 2 * k].y, (float)o[t * 16 + 2 * k + 1].x, (float)o[t * 16 + 2 * k + 1].y};
                    const f32x4 v = xa + ga * ov; xn[t * 8 + k] = v; ss += v[0] * v[0] + v[1] * v[1] + v[2] * v[2] + v[3] * v[3];
                    if (l < 3) *(u32x2*)xp = (u32x2){pk_bf16(v[0], v[1]), pk_bf16(v[2], v[3])}; }
            ss = half_sum(ss);
            const float rstd = __frsqrt_rn(ss * (1.0f / 2048.0f) + EPS);
            if (l < 3) {
                const float* nw = F.norm_w + (size_t)(l + 1) * 2 * D; const float* mn = F.MOD + (size_t)((l + 1) * 3 + grp) * 12288;
#pragma unroll
                for (int t = 0; t < 2; ++t)
#pragma unroll
                    for (int k = 0; k < 8; ++k) { const int cidx = le * 4 + t * 1024 + k * 128;
                        const f32x4 nv = *(const f32x4*)(nw + cidx), sc = *(const f32x4*)(mn + 2048 + cidx), sh = *(const f32x4*)(mn + cidx);
                        const f32x4 hv = xn[t * 8 + k] * rstd * nv * (1.0f + sc) + sh;
                        *(u32x2*)(F.HB + (size_t)tok * D + cidx) = (u32x2){pk_bf16(hv[0], hv[1]), pk_bf16(hv[2], hv[3])}; }
            } else {
                float* yo = F.out + (size_t)tok * D + le * 4;
#pragma unroll
                for (int t = 0; t < 2; ++t)
#pragma unroll
                    for (int k = 0; k < 8; ++k) { const f32x4 na = *(const f32x4*)(F.final_norm_w + le * 4 + t * 1024 + k * 128); *(f32x4*)(yo + t * 1024 + k * 128) = xn[t * 8 + k] * rstd * na; }
            }
        }
    }
}

__global__ void __launch_bounds__(512, 2) mk_fwd(Args args) {
    extern __shared__ __attribute__((aligned(16))) unsigned char lds_raw[];
    Frame F;
    F.lds = (LAS unsigned char*)lds_raw; F.tid = threadIdx.x; F.lane = F.tid & 63; F.wave = __builtin_amdgcn_readfirstlane(F.tid >> 6);
    F.x_prompt = args.in[0]; F.x_sample = args.in[1]; F.state_in = args.in[2]; F.c = args.in[3]; F.c_ctx = args.in[4]; F.w_ada = args.in[5]; F.b_ada = args.in[6]; F.norm_w = args.in[7];
    F.w_in = args.in[8]; F.lower_bounds = args.in[9]; F.hgrn_norm_w = args.in[10]; F.w_pool = args.in[11]; F.pool_scale = args.in[12]; F.w_out = args.in[13]; F.w_query = args.in[14];
    F.sub_keys = args.in[15]; F.expert_u = args.in[16]; F.expert_v = args.in[17]; F.final_norm_w = args.in[18];
    unsigned char* ws = args.ws; F.out = args.out;
    F.MOD = (float*)(ws + WS_MOD); F.LB = (float*)(ws + WS_LB); F.WIN = (bf16_t*)(ws + WS_WIN); F.WOUT = (bf16_t*)(ws + WS_WOUT); F.WQ = (bf16_t*)(ws + WS_WQ); F.WINU = (bf16_t*)(ws + WS_WINU);
    F.WPOOL = (bf16_t*)(ws + WS_WPOOL); F.KEYS = (bf16_t*)(ws + WS_KEYS); F.UTAB = ws + WS_UTAB; F.VTAB = ws + WS_VTAB; F.USC = (float*)(ws + WS_USC); F.VSC = (float*)(ws + WS_VSC); F.X = (float*)(ws + WS_X); F.XB = (bf16_t*)(ws + WS_X); F.HB = (bf16_t*)(ws + WS_HB);
    F.P = (bf16_t*)(ws + WS_P); F.OF = (float*)(ws + WS_OF); F.OB = (float*)(ws + WS_OB); F.CAT = (bf16_t*)(ws + WS_CAT); F.Q = (bf16_t*)(ws + WS_Q); F.SELI = (int*)(ws + WS_SELI); F.SELG = (float*)(ws + WS_SELG); F.MODP = (float*)(ws + WS_MODP); F.QH = (bf16_t*)(ws + WS_QH); F.SSEG = (float*)(ws + WS_SSEG); F.DSEG = (float*)(ws + WS_DSEG);
    const int lo = args.ph_lo, hi = args.ph_hi;
    volatile LAS unsigned* misc = (volatile LAS unsigned*)(F.lds + MISC_OFF);
    if (F.tid < 4) misc[F.tid] = 0u;
    __syncthreads();
    XcdBarrier bar; bar.bar = (unsigned*)(ws + WS_CTL); bar.x = 0; bar.st = misc;
    if (hi - lo > 1) bar = xcd_barrier_post((unsigned*)(ws + WS_CTL), misc);
#define IN(k) (lo <= (k) && (k) < hi)
#define SEAM(k) do { if ((k) + 1 < hi) xcd_barrier(bar); } while (0)
    const int G = gridDim.x, bx = blockIdx.x;
    if (IN(0)) { for (int rep = 0; rep < NREP(0); ++rep) { if (KIND_ON(0)) p0_prologue(F); __syncthreads(); } SEAM(0); }
    if (IN(1)) {
        if (KIND_ON(1)) {
            pg8::Gemm g{F.WPOOL, F.WINU, 4096, 32768, 256, 256, 256}; pg8::PoolFoldOrder S{G, bx}; pg8::EpiPoolFold E{F.WIN};
            pg8::gemm_phase<pg8::EpiPoolFold, pg8::PoolFoldOrder>(F.lds, g, S, E, F.wave);
        }
        if (KIND_ON(6)) {
            for (int i = bx * 512 + fresh_tid(F.wave); i < 4 * 3 * 12288; i += G * 512) F.MOD[i] = ((F.MODP[i] + F.MODP[MODP_STRIDE + i]) + F.MODP[2 * MODP_STRIDE + i]) + F.MODP[3 * MODP_STRIDE + i];
            norm_rows<4, false>(F, F.x_prompt, F.x_sample, F.norm_w, F.MODP, 0, 2048);
        }
        SEAM(1);
    }
    for (int l = 0; l < 4; ++l) {
        const int pb = 2 + 9 * l;
        if (IN(pb) && KIND_ON(2)) for (int rep = 0; rep < NREP(2); ++rep) {
            pg8::Gemm g{F.HB, F.WIN + (size_t)l * 6144 * 2048, NTOK, DIN, D, D, D}; pg8::StaticOrder S; S.init(NTOK, DIN, G, bx); pg8::EpiBf16 E{F.P, DIN};
            pg8::gemm_phase<pg8::EpiBf16, pg8::StaticOrder>(F.lds, g, S, E, F.wave);
            if (rep == NREP(2) - 1) SEAM(pb);
        }
        if (IN(pb + 1)) { for (int rep = 0; rep < NREP(3); ++rep) { if (KIND_ON(3)) p3_scan(F, l); __syncthreads(); } SEAM(pb + 1); }
        if (IN(pb + 2)) { if (KIND_ON(3)) p3c_correct(F, l); SEAM(pb + 2); }
        if (IN(pb + 3)) { for (int rep = 0; rep < NREP(4); ++rep) if (KIND_ON(4)) p4_combine(F, l); SEAM(pb + 3); }
        if (IN(pb + 4) && KIND_ON(5)) {
            pg8::Gemm g{F.CAT, F.WOUT + (size_t)l * D * D, NTOK, D, D, D, D}; pg8::StaticOrder S; S.init(NTOK, D, G, bx);
            pg8::EpiRes E{l == 0 ? F.x_prompt : nullptr, l == 0 ? F.x_sample : nullptr, l == 0 ? nullptr : F.XB, F.XB, F.MOD + (size_t)l * 3 * 12288 + 4096};
            pg8::gemm_phase<pg8::EpiRes, pg8::StaticOrder>(F.lds, g, S, E, F.wave);
            SEAM(pb + 4);
        }
        if (IN(pb + 5)) { for (int rep = 0; rep < NREP(6); ++rep) if (KIND_ON(6)) norm_rows<1, true>(F, F.XB, F.XB + (size_t)TP * D, F.norm_w + (size_t)(l * 2 + 1) * D, F.MOD + (size_t)l * 3 * 12288, 6144, 8192); SEAM(pb + 5); }
        if (IN(pb + 6) && KIND_ON(7)) {
            pg8::Gemm g{F.HB, F.WQ + (size_t)l * D * D, NTOK, D, D, D, D}; pg8::StaticOrder S; S.init(NTOK, D, G, bx); pg8::EpiBf16 E{F.Q, D};
            const bool early = (bx >> 3) & 1, odd = F.wave & 1;
#pragma unroll 1
            for (int st = 0; st < 4; ++st) {
                if (st == 1) {
                    pg8::gemm_phase<pg8::EpiBf16, pg8::StaticOrder>(F.lds, g, S, E, F.wave);
                    asm volatile("s_waitcnt vmcnt(0)" ::: "memory");
                    __syncthreads();
                    if (F.tid == 0) { __builtin_amdgcn_fence(__ATOMIC_ACQUIRE, "agent"); asm volatile("s_waitcnt vmcnt(0)" ::: "memory"); }
                    __syncthreads();
                    continue;
                }
                const bool cv = early ? (st == 0) : ((st == 2 && !odd) || (st == 3 && odd));
                const bool tk = early ? (st == 2) : ((st == 2 && odd) || (st == 3 && !odd));
                if (cv && KIND_ON(8)) conv_tables(F, l);
                if (tk && KIND_ON(8)) p8_topk(F, l, S);
            }
            SEAM(pb + 6);
        }
        if (IN(pb + 8)) { if (KIND_ON(9)) p9_peer(F, l); SEAM(pb + 8); }
    }
}

extern "C" void kernel_launch(void* const* d_in, const int* in_sizes, int n_in, void* d_out, int out_size, void* d_ws, size_t ws_size, hipStream_t stream) {
    static int grid = 0;
    if (grid == 0) {
        if (n_in != 19 || ws_size < WS_END) { fprintf(stderr, "kernel_launch: expected 19 inputs and >= %zu bytes of workspace, got %d / %zu\n", (size_t)WS_END, n_in, ws_size); grid = -1; return; }
        int dev = 0, cus = 0, per_cu = 0;
        if (hipGetDevice(&dev) != hipSuccess || hipDeviceGetAttribute(&cus, hipDeviceAttributeMultiprocessorCount, dev) != hipSuccess) { grid = -1; return; }
        if (hipFuncSetAttribute((const void*)mk_fwd, hipFuncAttributeMaxDynamicSharedMemorySize, LDS_BYTES) != hipSuccess) { fprintf(stderr, "kernel_launch: hipFuncSetAttribute failed\n"); grid = -1; return; }
        if (hipOccupancyMaxActiveBlocksPerMultiprocessor(&per_cu, (const void*)mk_fwd, 512, LDS_BYTES) != hipSuccess || per_cu < 1) { fprintf(stderr, "kernel_launch: occupancy query says %d\n", per_cu); }
        (void)hipGetLastError();
        grid = cus;
    }
    if (grid < 0) return;
    (void)hipMemsetAsync((char*)d_ws + WS_CTL, 0, WS_MOD - WS_CTL, stream);
    Args a{};
    for (int i = 0; i < 19; ++i) a.in[i] = (const float*)d_in[i];
    a.out = (float*)d_out; a.ws = (unsigned char*)d_ws;
#if MK_ONE_LAUNCH
    a.ph_lo = 0; a.ph_hi = NPHASE;
    hipLaunchKernelGGL(mk_fwd, dim3(grid), dim3(512), LDS_BYTES, stream, a);
#else
    for (int ph = 0; ph < NPHASE; ++ph) { a.ph_lo = ph; a.ph_hi = ph + 1; hipLaunchKernelGGL(mk_fwd, dim3(grid), dim3(512), LDS_BYTES, stream, a); }
#endif
}
```

```cpp
#include <hip/hip_runtime.h>
#include <cstdio>
#include <cstdint>

#ifndef MK_ONE_LAUNCH
#define MK_ONE_LAUNCH 1
#endif
#ifndef MK_KIND_MASK
#define MK_KIND_MASK 0x3ff
#endif
#define KIND_ON(k) (((MK_KIND_MASK) >> (k)) & 1)
#ifndef MK_REPEAT_MASK
#define MK_REPEAT_MASK 0
#endif
#define NREP(k) (1 + (((MK_REPEAT_MASK) >> (k)) & 1))

#define DI __device__ __forceinline__
#define LAS __attribute__((address_space(3)))

typedef unsigned short bf16_t;
typedef short bf16x8 __attribute__((ext_vector_type(8)));
typedef float f32x2 __attribute__((ext_vector_type(2)));
typedef float f32x4 __attribute__((ext_vector_type(4)));
typedef float f32x16 __attribute__((ext_vector_type(16)));
typedef unsigned u32x2 __attribute__((ext_vector_type(2)));
typedef unsigned u32x4 __attribute__((ext_vector_type(4)));
typedef unsigned u32x6 __attribute__((ext_vector_type(6)));
typedef float f32x32 __attribute__((ext_vector_type(32)));
typedef _Float16 h2v __attribute__((ext_vector_type(2)));
typedef _Float16 h32v __attribute__((ext_vector_type(32)));
typedef __bf16 bf16x2_t __attribute__((ext_vector_type(2)));

constexpr int D = 2048, NTOK = 8192, TP = 4096, DIN = 6144, NMOD = 12288, NEXP = 16384;
constexpr float EPS = 1e-6f;
constexpr int NPHASE = 38;
constexpr int ROWB = 1152;

constexpr size_t WS_CTL = 0;
constexpr size_t WS_MOD = 65536;
constexpr size_t WS_LB = WS_MOD + (size_t)4 * 3 * 12288 * 4;
constexpr size_t WS_WIN = WS_LB + (size_t)2 * 4 * 1024 * 4;
constexpr size_t WS_WOUT = WS_WIN + (size_t)4 * 6144 * 2048 * 2;
constexpr size_t WS_WQ = WS_WOUT + (size_t)4 * 2048 * 2048 * 2;
constexpr size_t WS_WINU = WS_WQ + (size_t)4 * 2048 * 2048 * 2;
constexpr size_t WS_WPOOL = WS_WINU + (size_t)16 * 2048 * 256 * 2;
constexpr size_t WS_KEYS = WS_WPOOL + (size_t)16 * 256 * 256 * 2;
constexpr size_t WS_UTAB = WS_KEYS + (size_t)4 * 8 * 2 * 128 * 128 * 2;
constexpr size_t WS_VTAB = WS_UTAB + (size_t)4 * 16384 * 2048;
constexpr size_t WS_X = WS_VTAB + (size_t)4 * 16384 * 2048;
constexpr size_t WS_HB = WS_X + (size_t)8192 * 2048 * 4;
constexpr size_t WS_P = WS_HB + (size_t)8192 * 2048 * 2;
constexpr size_t WS_OF = WS_P + (size_t)8192 * 6144 * 2;
constexpr size_t WS_OB = WS_OF + (size_t)8192 * 1024 * 4;
constexpr size_t WS_CAT = WS_OB + (size_t)8192 * 1024 * 4;
constexpr size_t WS_Q = WS_CAT + (size_t)8192 * 2048 * 2;
constexpr size_t WS_SELI = WS_Q + (size_t)8192 * 2048 * 2;
constexpr size_t WS_SELG = WS_SELI + (size_t)8192 * 128 * 4;
constexpr size_t WS_MODP = WS_SELG + (size_t)8192 * 128 * 4;
constexpr size_t WS_USC = WS_MODP + (size_t)4 * 4 * 3 * 12288 * 4;
constexpr size_t WS_VSC = WS_USC + (size_t)4 * 16384 * 4;
constexpr size_t WS_QH = WS_VSC + (size_t)4 * 16384 * 4;
constexpr size_t WS_SSEG = WS_QH + (size_t)2 * 4096 * 1024 * 2;
constexpr size_t WS_DSEG = WS_SSEG + (size_t)256 * 16384 * 4;
constexpr size_t WS_END = WS_DSEG + (size_t)256 * 128 * 4;
constexpr size_t MODP_STRIDE = (size_t)4 * 3 * 12288;

constexpr int LDS_BYTES = 155648;
constexpr int MISC_OFF = LDS_BYTES - 256;

DI unsigned pk_bf16(float lo, float hi) { f32x2 v = {lo, hi}; bf16x2_t b = __builtin_convertvector(v, bf16x2_t); return __builtin_bit_cast(unsigned, b); }
DI float bf_lo(unsigned x) { return __uint_as_float(x << 16); }
DI float bf_hi(unsigned x) { return __uint_as_float(x & 0xffff0000u); }
template <int M> DI float xshfl(float v) {
    if constexpr (M < 32) return __int_as_float(__builtin_amdgcn_ds_swizzle(__float_as_int(v), (M << 10) | 0x1f));
    else { unsigned z = 0u; asm volatile("; rebuilt at each use, never kept" : "+v"(z)); const unsigned ad = (__builtin_amdgcn_mbcnt_hi(~0u, __builtin_amdgcn_mbcnt_lo(~0u, z)) ^ 32u) << 2; return __int_as_float(__builtin_amdgcn_ds_bpermute((int)ad, __float_as_int(v))); }
}
DI float wave_sum(float v) { v += xshfl<32>(v); v += xshfl<16>(v); v += xshfl<8>(v); v += xshfl<4>(v); v += xshfl<2>(v); v += xshfl<1>(v); return v; }
DI float fdot2(unsigned a, unsigned b, float c) { return __builtin_amdgcn_fdot2_f32_bf16(__builtin_bit_cast(bf16x2_t, a), __builtin_bit_cast(bf16x2_t, b), c, false); }
DI float silu_f(float x) { return x / (1.f + __expf(-x)); }
#define MFMA32(a, b, c) __builtin_amdgcn_mfma_f32_32x32x16_bf16((a), (b), (c), 0, 0, 0)
DI int fresh_tid(const int wave_s) { unsigned z = 0u; asm volatile("; fresh lane id" : "+v"(z)); const int t = (int)__builtin_amdgcn_mbcnt_hi(~0u, __builtin_amdgcn_mbcnt_lo(~0u, z)); return (wave_s << 6) | t; }
DI int crow(int i, int hh) { return (i & 3) + 8 * (i >> 2) + 4 * hh; }

#define XB_TMO      128
#define XB_XCNT(j)  (256  + 64 * (j))
#define XB_XSUB(j)  (1280 + 64 * (j))
#define XB_XGEN(j)  (2304 + 64 * (j))
#define XB_TOP      3328
#define XB_TOPGEN   3392
#define XCD_BAR_WORDS 3456
#define XB_SPIN_CAP (1u << 18)

__device__ __forceinline__ unsigned xb_ld(unsigned* p)              { return __hip_atomic_load(p, __ATOMIC_RELAXED, __HIP_MEMORY_SCOPE_AGENT); }
__device__ __forceinline__ unsigned xb_add(unsigned* p, unsigned v) { return __hip_atomic_fetch_add(p, v, __ATOMIC_RELAXED, __HIP_MEMORY_SCOPE_AGENT); }
__device__ __forceinline__ unsigned xb_xcc_id() { return (unsigned)__builtin_amdgcn_s_getreg((3 << 11) | 20) & 0xFu; }
#define XB_SPIN(cond, bar) do { unsigned _sp = 0; while (cond) { __builtin_amdgcn_s_sleep(1); \
    if ((++_sp & 255u) == 0u) { if (xb_ld(&(bar)[XB_TMO])) break; if (_sp > XB_SPIN_CAP) { atomicAdd(&(bar)[XB_TMO], 1u); break; } } } } while (0)

struct XcdBarrier {
    unsigned* bar; unsigned x;
    volatile LAS unsigned* st;
};
__device__ __forceinline__ XcdBarrier xcd_barrier_post(unsigned* bar, volatile LAS unsigned* st) {
    XcdBarrier b; b.bar = bar; b.x = xb_xcc_id(); b.st = st;
    if (threadIdx.x == 0) (void)xb_add(&bar[XB_XCNT(b.x)], 1u);
    return b;
}
__device__ __forceinline__ void xcd_barrier_complete(unsigned* bar, unsigned x, unsigned& nloc, unsigned& nx) {
    const unsigned G = gridDim.x * gridDim.y * gridDim.z;
    unsigned sum, cnt, mine, sp = 0u;
    for (;;) {
        sum = 0u; cnt = 0u; mine = 0u;
#pragma unroll
        for (unsigned j = 0; j < 16; ++j) { const unsigned c = xb_ld(&bar[XB_XCNT(j)]); sum += c; cnt += (c > 0u) ? 1u : 0u; mine = (j == x) ? c : mine; }
        if (sum == G) break;
        __builtin_amdgcn_s_sleep(1);
        if ((++sp & 255u) == 0u) { if (xb_ld(&bar[XB_TMO])) break; if (sp > XB_SPIN_CAP) { atomicAdd(&bar[XB_TMO], 1u); break; } }
    }
    nloc = mine > 0u ? mine : 1u; nx = cnt > 0u ? cnt : 1u;
}
__device__ __forceinline__ void xcd_barrier(const XcdBarrier& b) {
    asm volatile("s_waitcnt vmcnt(0)" ::: "memory");
    __syncthreads();
    if (threadIdx.x == 0) {
        unsigned* bar = b.bar;
        __builtin_amdgcn_s_waitcnt(0);
        unsigned nloc = b.st[0], nx = b.st[1];
        if (nloc == 0u) { xcd_barrier_complete(bar, b.x, nloc, nx); b.st[0] = nloc; b.st[1] = nx; }
        const unsigned old = xb_add(&bar[XB_XSUB(b.x)], 1u);
        const unsigned gen = old / nloc;
        if (old + 1u == (gen + 1u) * nloc) {
            __builtin_amdgcn_fence(__ATOMIC_RELEASE, "agent");
            asm volatile("s_waitcnt vmcnt(0)" ::: "memory");
            const unsigned og = xb_add(&bar[XB_TOP], 1u);
            const unsigned tg = og / nx;
            if (og + 1u == (tg + 1u) * nx) xb_add(&bar[XB_TOPGEN], 1u);
            else XB_SPIN(xb_ld(&bar[XB_TOPGEN]) == tg, bar);
            __builtin_amdgcn_fence(__ATOMIC_ACQUIRE, "agent");
            xb_add(&bar[XB_XGEN(b.x)], 1u);
            asm volatile("s_waitcnt vmcnt(0)" ::: "memory");
        } else {
            XB_SPIN(xb_ld(&bar[XB_XGEN(b.x)]) == gen, bar);
            __builtin_amdgcn_fence(__ATOMIC_ACQUIRE, "agent");
            asm volatile("s_waitcnt vmcnt(0)" ::: "memory");
        }
    }
    __syncthreads();
}

namespace pg8 {
constexpr int BM = 256, BK = 64, HALF = 128, HTB = HALF * BK * 2, STAGE_BYTES = 8 * HTB, NXCD = 8, WGM = 8;
__host__ __device__ __forceinline__ int lds_byte(int r, int c) { const int st = (r >> 4) * 2 + (c >> 5), rr = r & 15, cc = c & 31, ob = rr * 64 + cc * 2; return st * 1024 + (ob ^ (((ob >> 9) & 1) << 5)); }
__host__ __device__ __forceinline__ void stage_rc(int b, int& R, int& C) { const int st = b / 1024, sb = b % 1024, swz = sb ^ (((sb >> 9) & 1) << 5); R = (st >> 1) * 16 + swz / 64; C = (st & 1) * 32 + (swz % 64) / 2; }
__host__ __device__ __forceinline__ int perm32(int rho) { const int n = rho >> 4, i = rho & 15; return 8 * (i >> 2) + 4 * n + (i & 3); }

struct Unit { int pm, pn; };
struct Gemm { const bf16_t* A; const bf16_t* Bt; int M, N, K, lda, ldb; };

struct StaticOrder {
    int nM, nN, nwg, G, c;
    __host__ __device__ void init(int M, int N, int G_, int c_) { nM = M / BM; nN = N / BM; nwg = nM * nN; G = G_; c = c_; }
    __host__ __device__ bool next(int i, Unit& u) const {
        const long L = (long)i * G + c; if (L >= nwg) return false;
        int wgid = (int)L; { const int q = nwg / NXCD, r = nwg % NXCD, xcd = wgid % NXCD, off = wgid / NXCD; wgid = (xcd < r ? xcd * (q + 1) : r * (q + 1) + (xcd - r) * q) + off; }
        const int nig = WGM * nN, gid = wgid / nig, fm = gid * WGM, gsz = (nM - fm) < WGM ? (nM - fm) : WGM;
        u.pm = fm + ((wgid % nig) % gsz); u.pn = (wgid % nig) / gsz; return true;
    }
    __device__ __forceinline__ void a_ready(const Unit&) const {}
    __device__ __forceinline__ void done(const Unit&) const {}
};
struct PoolFoldOrder {
    int G, c;
    __device__ bool next(int i, Unit& u) const { const int L = i * G + c; if (L >= 128) return false; u.pm = L >> 3; u.pn = L; return true; }
    __device__ __forceinline__ void a_ready(const Unit&) const {}
    __device__ __forceinline__ void done(const Unit&) const {}
};

struct EpiBf16 {
    static constexpr bool PERM = true, AFTER_DRAIN = false;
    bf16_t* O; int ldc;
    __device__ __forceinline__ void operator()(const f32x4 (&acc)[2][2][4][2], const Unit& u, int wr, int wc, int fr, int fq) const {
        const int row0 = u.pm * BM + wr * 64 + fr; const int col0 = u.pn * BM + wc * 32 + 8 * fq;
#pragma unroll
        for (int ai = 0; ai < 2; ++ai)
#pragma unroll
            for (int m = 0; m < 4; ++m) { bf16_t* rowp = O + (size_t)(row0 + ai * HALF + m * 16) * ldc + col0;
#pragma unroll
                for (int bj = 0; bj < 2; ++bj) { const f32x4 v0 = acc[ai][bj][m][0], v1 = acc[ai][bj][m][1];
                    u32x4 w; w.x = pk_bf16(v0[0], v0[1]); w.y = pk_bf16(v0[2], v0[3]); w.z = pk_bf16(v1[0], v1[1]); w.w = pk_bf16(v1[2], v1[3]);
                    *(u32x4*)(rowp + bj * HALF) = w; } }
    }
};
struct EpiPoolFold {
    static constexpr bool PERM = true, AFTER_DRAIN = false;
    bf16_t* WIN;
    __device__ __forceinline__ void operator()(const f32x4 (&acc)[2][2][4][2], const Unit& u, int wr, int wc, int fr, int fq) const {
        const int lg = u.pm, l = lg >> 2, g = lg & 3, kt = u.pn & 7;
        bf16_t* base = WIN + ((size_t)l * 6144 + 5120 + g * 256) * 2048 + kt * 256;
        const int row0 = wr * 64 + fr, col0 = wc * 32 + 8 * fq;
#pragma unroll
        for (int ai = 0; ai < 2; ++ai)
#pragma unroll
            for (int m = 0; m < 4; ++m) { bf16_t* rowp = base + (size_t)(row0 + ai * HALF + m * 16) * 2048 + col0;
#pragma unroll
                for (int bj = 0; bj < 2; ++bj) { const f32x4 v0 = acc[ai][bj][m][0], v1 = acc[ai][bj][m][1];
                    u32x4 w; w.x = pk_bf16(v0[0], v0[1]); w.y = pk_bf16(v0[2], v0[3]); w.z = pk_bf16(v1[0], v1[1]); w.w = pk_bf16(v1[2], v1[3]);
                    *(u32x4*)(rowp + bj * HALF) = w; } }
    }
};
struct EpiRes {
    static constexpr bool PERM = true, AFTER_DRAIN = false;
    const float* xin_p; const float* xin_s; const bf16_t* xin_b; bf16_t* xout; const float* gate;
    __device__ __forceinline__ void operator()(const f32x4 (&acc)[2][2][4][2], const Unit& u, int wr, int wc, int fr, int fq) const {
        const int row0 = u.pm * BM + wr * 64 + fr, col0 = u.pn * BM + wc * 32 + 8 * fq;
        const int grp = (u.pm < 16) ? 0 : 1 + ((u.pm - 16) >> 3);
        const float* gp = gate + (size_t)grp * 12288 + col0;
        f32x4 gv[2][2];
#pragma unroll
        for (int bj = 0; bj < 2; ++bj)
#pragma unroll
            for (int n = 0; n < 2; ++n) gv[bj][n] = *(const f32x4*)(gp + bj * HALF + n * 4);
#pragma unroll
        for (int ai = 0; ai < 2; ++ai)
#pragma unroll
            for (int m = 0; m < 4; ++m) { const int row = row0 + ai * HALF + m * 16;
#pragma unroll
                for (int bj = 0; bj < 2; ++bj) { f32x4 x0, x1;
                    if (xin_b) { const u32x4 w = *(const u32x4*)(xin_b + (size_t)row * D + col0 + bj * HALF); x0 = (f32x4){bf_lo(w.x), bf_hi(w.x), bf_lo(w.y), bf_hi(w.y)}; x1 = (f32x4){bf_lo(w.z), bf_hi(w.z), bf_lo(w.w), bf_hi(w.w)}; }
                    else { const float* xi = (row < TP ? xin_p + (size_t)row * D : xin_s + (size_t)(row - TP) * D) + col0 + bj * HALF; x0 = *(const f32x4*)xi; x1 = *(const f32x4*)(xi + 4); }
                    const f32x4 r0 = x0 + gv[bj][0] * acc[ai][bj][m][0], r1 = x1 + gv[bj][1] * acc[ai][bj][m][1];
                    u32x4 o; o.x = pk_bf16(r0[0], r0[1]); o.y = pk_bf16(r0[2], r0[3]); o.z = pk_bf16(r1[0], r1[1]); o.w = pk_bf16(r1[2], r1[3]);
                    *(u32x4*)(xout + (size_t)row * D + col0 + bj * HALF) = o; } }
    }
};

template <class Epi, class Sched>
__device__ __forceinline__ void gemm_phase(LAS unsigned char* lds, const Gemm g, const Sched& S, const Epi& E, const int wave_s) {
    const int tid = fresh_tid(wave_s), wid = __builtin_amdgcn_readfirstlane(tid >> 6), lane = tid & 63, wr = wid >> 2, wc = wid & 3, fr = lane & 15, fq = lane >> 4;
    const int K = g.K, nt = K / BK;
    unsigned voffA[2], voffB[2];
#pragma unroll
    for (int i = 0; i < 2; ++i) { int R, C; stage_rc(tid * 16 + i * 8192, R, C); const int Rb = Epi::PERM ? ((R & ~31) + perm32(R & 31)) : R;
        voffA[i] = (unsigned)(R * g.lda + C) * 2u; voffB[i] = (unsigned)(Rb * g.ldb + C) * 2u; }
    const size_t kstep = (size_t)(BK * 2);
    const size_t hstepA = (size_t)HALF * g.lda * 2, hstepB = (size_t)HALF * g.ldb * 2;
    const size_t tstepA = 2 * hstepA, tstepB = 2 * hstepB;
    const unsigned ldsw = (unsigned)wid * 1024u;
    const int aoff = lds_byte(wr * 64 + fr, fq * 8), boff = lds_byte(wc * 32 + fr, fq * 8);
#define PG8_SA(b, h) (((b) * 2 + (h)) * HTB)
#define PG8_SB(b, h) ((4 + (b) * 2 + (h)) * HTB)
#define PG8_STAGE(bufoff, gbase, voff) do { _Pragma("unroll") for (int _i = 0; _i < 2; ++_i) \
        __builtin_amdgcn_global_load_lds((const unsigned*)((const char*)(gbase) + (voff)[_i]), (LAS unsigned*)(lds + (bufoff) + ldsw + _i * 8192), 16, 0, 0); } while (0)
#define PG8_LDA(dst, b, h) do { _Pragma("unroll") for (int m = 0; m < 4; ++m) _Pragma("unroll") for (int k = 0; k < 2; ++k) dst[m][k] = *(const LAS bf16x8*)(lds + PG8_SA(b, h) + aoff + m * 2048 + k * 1024); } while (0)
#define PG8_LDB(dst, b, h) do { _Pragma("unroll") for (int n = 0; n < 2; ++n) _Pragma("unroll") for (int k = 0; k < 2; ++k) dst[n][k] = *(const LAS bf16x8*)(lds + PG8_SB(b, h) + boff + n * 2048 + k * 1024); } while (0)
#define PG8_MMA(ai, bj, At, Bt) do { __builtin_amdgcn_s_setprio(1); _Pragma("unroll") for (int m = 0; m < 4; ++m) _Pragma("unroll") for (int n = 0; n < 2; ++n) _Pragma("unroll") for (int k = 0; k < 2; ++k) \
        acc[ai][bj][m][n] = __builtin_amdgcn_mfma_f32_16x16x32_bf16(Bt[n][k], At[m][k], acc[ai][bj][m][n], 0, 0, 0); __builtin_amdgcn_s_setprio(0); } while (0)
#define PG8_WAIT_V(n) asm volatile("s_waitcnt vmcnt(" #n ")" ::: "memory")
#define PG8_WAIT_L(n) asm volatile("s_waitcnt lgkmcnt(" #n ")" ::: "memory")
#define PG8_BAR __builtin_amdgcn_s_barrier()
#define PG8_SCHED __builtin_amdgcn_sched_barrier(0)
    Unit cur, nxt; int ui = 0;
    if (!S.next(0, cur)) return;
    f32x4 acc[2][2][4][2];
#pragma unroll
    for (int a = 0; a < 2; ++a)
#pragma unroll
        for (int b = 0; b < 2; ++b)
#pragma unroll
            for (int m = 0; m < 4; ++m)
#pragma unroll
                for (int n = 0; n < 2; ++n) acc[a][b][m][n] = (f32x4){0.f, 0.f, 0.f, 0.f};
    bf16x8 At[4][2], B0[2][2], B1[2][2];
    const char* cA = (const char*)g.A + (size_t)cur.pm * tstepA; const char* cB = (const char*)g.Bt + (size_t)cur.pn * tstepB;
    S.a_ready(cur);
    PG8_STAGE(PG8_SB(0, 0), cB, voffB); PG8_STAGE(PG8_SA(0, 0), cA, voffA); PG8_STAGE(PG8_SB(0, 1), cB + hstepB, voffB); PG8_STAGE(PG8_SA(0, 1), cA + hstepA, voffA);
    if (wr == 1) PG8_BAR;
    PG8_WAIT_V(4); PG8_BAR;
    PG8_STAGE(PG8_SB(1, 0), cB + kstep, voffB); PG8_STAGE(PG8_SA(1, 0), cA + kstep, voffA); PG8_STAGE(PG8_SB(1, 1), cB + hstepB + kstep, voffB);
    PG8_WAIT_V(6); PG8_BAR;
    for (;;) {
        const bool has_next = S.next(ui + 1, nxt);
        const char* nA = has_next ? (const char*)g.A + (size_t)nxt.pm * tstepA : cA; const char* nB = has_next ? (const char*)g.Bt + (size_t)nxt.pn * tstepB : cB;
        for (int t = 0; t < nt; t += 2) {
            const bool last = (t == nt - 2);
            const char* a1 = cA + (size_t)(t + 1) * kstep;
            const char* a2 = last ? nA : cA + (size_t)(t + 2) * kstep; const char* b2 = last ? nB : cB + (size_t)(t + 2) * kstep;
            const char* a3 = a2 + kstep; const char* b3 = b2 + kstep;
            if (last && has_next) S.a_ready(nxt);
            PG8_LDB(B0, 0, 0); PG8_SCHED; PG8_LDA(At, 0, 0); PG8_STAGE(PG8_SA(1, 1), a1 + hstepA, voffA);
            PG8_WAIT_L(8); PG8_BAR; PG8_WAIT_L(0); PG8_MMA(0, 0, At, B0); PG8_BAR; PG8_SCHED;
            PG8_LDB(B1, 0, 1); PG8_STAGE(PG8_SB(0, 0), b2, voffB);
            PG8_BAR; PG8_WAIT_L(0); PG8_MMA(0, 1, At, B1); PG8_BAR;
            PG8_LDA(At, 0, 1); PG8_STAGE(PG8_SA(0, 0), a2, voffA);
            PG8_BAR; PG8_WAIT_L(0); PG8_MMA(1, 0, At, B0); PG8_BAR; PG8_SCHED;
            PG8_STAGE(PG8_SB(0, 1), b2 + hstepB, voffB);
            PG8_WAIT_V(6); PG8_BAR; PG8_MMA(1, 1, At, B1); PG8_BAR;
            PG8_LDB(B0, 1, 0); PG8_SCHED; PG8_LDA(At, 1, 0); PG8_STAGE(PG8_SA(0, 1), a2 + hstepA, voffA);
            PG8_WAIT_L(8); PG8_BAR; PG8_WAIT_L(0); PG8_MMA(0, 0, At, B0); PG8_BAR; PG8_SCHED;
            PG8_LDB(B1, 1, 1); PG8_STAGE(PG8_SB(1, 0), b3, voffB);
            PG8_BAR; PG8_WAIT_L(0); PG8_MMA(0, 1, At, B1); PG8_BAR;
            PG8_LDA(At, 1, 1); PG8_STAGE(PG8_SA(1, 0), a3, voffA);
            PG8_BAR; PG8_WAIT_L(0); PG8_MMA(1, 0, At, B0); PG8_BAR; PG8_SCHED;
            PG8_STAGE(PG8_SB(1, 1), b3 + hstepB, voffB);
            PG8_WAIT_V(6); PG8_BAR; PG8_MMA(1, 1, At, B1); PG8_BAR;
        }
        E(acc, cur, wr, wc, fr, fq); S.done(cur);
        if (!has_next) break;
#pragma unroll
        for (int a = 0; a < 2; ++a)
#pragma unroll
            for (int b = 0; b < 2; ++b)
#pragma unroll
                for (int m = 0; m < 4; ++m)
#pragma unroll
                    for (int n = 0; n < 2; ++n) acc[a][b][m][n] = (f32x4){0.f, 0.f, 0.f, 0.f};
        cur = nxt; cA = nA; cB = nB; ++ui;
    }
    PG8_WAIT_V(0);
    if (wr == 0) PG8_BAR;
    PG8_BAR;
#undef PG8_SA
#undef PG8_SB
#undef PG8_STAGE
#undef PG8_LDA
#undef PG8_LDB
#undef PG8_MMA
#undef PG8_WAIT_V
#undef PG8_WAIT_L
#undef PG8_BAR
#undef PG8_SCHED
}
}

struct Args { const float* in[19]; float* out; unsigned char* ws; int ph_lo, ph_hi; };
struct Frame {
    LAS unsigned char* lds; int tid, lane, wave;
    const float *x_prompt, *x_sample, *state_in, *c, *c_ctx, *w_ada, *b_ada, *norm_w, *w_in, *lower_bounds, *hgrn_norm_w, *w_pool, *pool_scale, *w_out, *w_query, *sub_keys, *expert_u, *expert_v, *final_norm_w;
    float* out; float* MOD; float* LB; bf16_t *WIN, *WOUT, *WQ, *WINU, *WPOOL, *KEYS; unsigned char *UTAB, *VTAB; float *USC, *VSC; float* X; bf16_t* XB; bf16_t *HB, *P; bf16_t *OF, *OB; bf16_t *CAT, *Q; int* SELI; float* SELG; float* MODP; bf16_t* QH; float *SSEG, *DSEG;
};

DI void p0_prologue(const Frame& F) {
    LAS float* sv = (LAS float*)(F.lds);
    LAS float* red = (LAS float*)(F.lds + 24576);
    LAS float* tile = (LAS float*)(F.lds + 49152);
    const int tid = fresh_tid(F.wave), lane = tid & 63, wave = __builtin_amdgcn_readfirstlane(tid >> 6), b = blockIdx.x, G = gridDim.x;
    for (int i = tid; i < 3 * 2048; i += 512) { const int g = i >> 11, k = i & 2047; const float cv = (g == 0) ? F.c_ctx[k] : F.c[(g - 1) * 2048 + k]; sv[i] = silu_f(cv); }
    __syncthreads();
    for (int task = b; task < 768; task += G) {
        const int l = task / 192, rem = task % 192, cb = rem >> 2, kq = rem & 3;
        const float* W = F.w_ada + (size_t)l * 2048 * 12288 + cb * 256 + lane * 4;
        const int r0 = kq * 512 + wave * 64;
        f32x4 a0 = {0.f, 0.f, 0.f, 0.f}, a1 = a0, a2 = a0;
#pragma unroll 8
        for (int r = r0; r < r0 + 64; ++r) {
            const f32x4 w = __builtin_nontemporal_load((const f32x4*)(W + (size_t)r * 12288));
            a0 += sv[r] * w; a1 += sv[2048 + r] * w; a2 += sv[4096 + r] * w;
        }
        LAS float* rp = red + (wave * 3) * 256 + lane * 4;
        *(LAS f32x4*)(rp) = a0; *(LAS f32x4*)(rp + 256) = a1; *(LAS f32x4*)(rp + 512) = a2;
        __syncthreads();
        for (int i = tid; i < 768; i += 512) { const int g = i >> 8, cc = i & 255; float s = 0.f;
#pragma unroll
            for (int w = 0; w < 8; ++w) s += red[(w * 3 + g) * 256 + cc];
            const int n = cb * 256 + cc; if (kq == 0) s += F.b_ada[l * 12288 + n];
            F.MODP[(size_t)kq * MODP_STRIDE + ((size_t)(l * 3 + g)) * 12288 + n] = s; }
        __syncthreads();
    }
    if (b == G - 1) {
        for (int i = tid; i < 2048; i += 512) { const int d = i >> 10, j = i & 1023; float v[4], m = -1e30f;
#pragma unroll
            for (int l = 0; l < 4; ++l) { v[l] = F.lower_bounds[(d * 4 + l) * 1024 + j]; m = fmaxf(m, v[l]); }
            float s = 0.f;
#pragma unroll
            for (int l = 0; l < 4; ++l) { v[l] = __expf(v[l] - m); s += v[l]; }
            const float inv = 1.f / s; float cum = 0.f; const float p0 = v[0] * inv;
#pragma unroll
            for (int l = 0; l < 4; ++l) { cum += v[l] * inv; F.LB[(d * 4 + l) * 1024 + j] = cum - p0; } }
    }
    constexpr int T_WIN = 4 * 3072, T_WOUT = 4 * 1024, T_WQ = 4 * 1024, T_WPOOL = 256, T_ALL = T_WIN + T_WOUT + T_WQ + T_WPOOL;
    for (int t = b; t < T_ALL; t += G) {
        const float* src; bf16_t* dst; int lsrc, ldst; bool plain = false;
        if (t < T_WIN) { const int l = t / 3072, r = t % 3072, kt = r / 96, nt = r % 96;
            src = F.w_in + (size_t)l * 2048 * 6144 + (size_t)(kt * 64) * 6144 + nt * 64; lsrc = 6144;
            if (nt < 80) { dst = F.WIN + (size_t)l * 6144 * 2048 + (size_t)(nt * 64) * 2048 + kt * 64; ldst = 2048; }
            else { const int n = nt * 64 - 5120, g = n >> 8, cc = n & 255; dst = F.WINU + ((size_t)(l * 4 + g) * 2048 + kt * 64) * 256 + cc; ldst = 256; plain = true; } }
        else if (t < T_WIN + T_WOUT + T_WQ) { const bool isq = t >= T_WIN + T_WOUT; const int tt = t - T_WIN - (isq ? T_WOUT : 0), l = tt >> 10, kt = (tt & 1023) >> 5, nt = tt & 31;
            src = (isq ? F.w_query : F.w_out) + (size_t)l * 2048 * 2048 + (size_t)(kt * 64) * 2048 + nt * 64; lsrc = 2048;
            dst = (isq ? F.WQ : F.WOUT) + (size_t)l * 2048 * 2048 + (size_t)(nt * 64) * 2048 + kt * 64; ldst = 2048; }
        else { const int tt = t - T_WIN - T_WOUT - T_WQ, mtx = tt >> 4, ct = (tt & 15) >> 2, dt = tt & 3;
            src = F.w_pool + (size_t)mtx * 65536 + (size_t)(ct * 64) * 256 + dt * 64; lsrc = 256;
            dst = F.WPOOL + (size_t)mtx * 65536 + (size_t)(dt * 64) * 256 + ct * 64; ldst = 256; }
        const int r = tid >> 4, c4 = (tid & 15) * 4;
        const f32x4 v0 = *(const f32x4*)(src + (size_t)r * lsrc + c4), v1 = *(const f32x4*)(src + (size_t)(r + 32) * lsrc + c4);
        if (plain) {
            u32x2 o0 = {pk_bf16(v0[0], v0[1]), pk_bf16(v0[2], v0[3])}, o1 = {pk_bf16(v1[0], v1[1]), pk_bf16(v1[2], v1[3])};
            *(u32x2*)(dst + (size_t)r * ldst + c4) = o0; *(u32x2*)(dst + (size_t)(r + 32) * ldst + c4) = o1;
        } else {
#pragma unroll
            for (int j = 0; j < 4; ++j) { tile[r * 65 + c4 + j] = v0[j]; tile[(r + 32) * 65 + c4 + j] = v1[j]; }
            __syncthreads();
            const int n = tid >> 3, kk = (tid & 7) * 8; float f[8];
#pragma unroll
            for (int j = 0; j < 8; ++j) f[j] = tile[(kk + j) * 65 + n];
            u32x4 o = {pk_bf16(f[0], f[1]), pk_bf16(f[2], f[3]), pk_bf16(f[4], f[5]), pk_bf16(f[6], f[7])};
            *(u32x4*)(dst + (size_t)n * ldst + kk) = o;
            __syncthreads();
        }
    }
    const size_t k8 = (size_t)4 * 8 * 2 * 128 * 128 / 8;
    for (size_t i = (size_t)b * 512 + tid; i < k8; i += (size_t)G * 512) {
        const f32x4* s = (const f32x4*)F.sub_keys + 2 * i; const f32x4 a = s[0], cc = s[1];
        u32x4 o = {pk_bf16(a[0], a[1]), pk_bf16(a[2], a[3]), pk_bf16(cc[0], cc[1]), pk_bf16(cc[2], cc[3])}; ((u32x4*)F.KEYS)[i] = o; }
}

DI void conv_tables(const Frame& F, const int l) {
    const int tid = fresh_tid(F.wave), lane = tid & 63, wave = __builtin_amdgcn_readfirstlane(tid >> 6), b = blockIdx.x, G = gridDim.x;
    for (int row = l * 16384 + b * 8 + wave; row < (l + 1) * 16384; row += G * 8) {
#pragma unroll
        for (int tb = 0; tb < 2; ++tb) {
            const float* src = (tb ? F.expert_v : F.expert_u) + (size_t)row * D + (lane >> 5) * 1024 + (lane & 31) * 4;
            f32x4 v[8]; float m = 0.f;
#pragma unroll
            for (int k = 0; k < 8; ++k) v[k] = __builtin_nontemporal_load((const f32x4*)(src + k * 128));
#pragma unroll
            for (int k = 0; k < 8; ++k) m = fmaxf(fmaxf(m, fmaxf(fabsf(v[k][0]), fabsf(v[k][1]))), fmaxf(fabsf(v[k][2]), fabsf(v[k][3])));
            float sc = m > 0.f ? m * (tb == 0 ? (1.0f / 7.0f) : (1.0f / 6.0f)) : 1.0f;
            const unsigned scb = (__float_as_uint(sc) + 0xffffu) >> 16; sc = __uint_as_float(scb << 16);
            const float inv = 1.0f / sc;
            unsigned pw[4];
            if (tb == 0) {
#pragma unroll
                for (int dd = 0; dd < 4; ++dd) { unsigned p = 0u;
#pragma unroll
                    for (int n = 0; n < 8; ++n) { const float xq = ((n < 4) ? v[2 * dd][n & 3] : v[2 * dd + 1][n & 3]) * inv; int q = (int)rintf(xq); q = q < -8 ? -8 : (q > 7 ? 7 : q); p |= (unsigned)(q & 15) << (4 * n); }
                    pw[dd] = p; }
            } else {
#pragma unroll
            for (int dd = 0; dd < 4; ++dd) { unsigned p = 0u;
                p = __builtin_amdgcn_cvt_scalef32_pk_fp4_f32(p, v[2 * dd][0] * inv, v[2 * dd][1] * inv, 1.0f, 0);
                p = __builtin_amdgcn_cvt_scalef32_pk_fp4_f32(p, v[2 * dd][2] * inv, v[2 * dd][3] * inv, 1.0f, 1);
                p = __builtin_amdgcn_cvt_scalef32_pk_fp4_f32(p, v[2 * dd + 1][0] * inv, v[2 * dd + 1][1] * inv, 1.0f, 2);
                p = __builtin_amdgcn_cvt_scalef32_pk_fp4_f32(p, v[2 * dd + 1][2] * inv, v[2 * dd + 1][3] * inv, 1.0f, 3);
                pw[dd] = p; }
            }
            unsigned char* dst = (tb ? F.VTAB : F.UTAB) + (size_t)row * ROWB;
            *(u32x4*)(dst + (lane & 31) * 32 + (lane >> 5) * 16) = (u32x4){pw[0], pw[1], pw[2], pw[3]};
            *(unsigned short*)(dst + 1024 + (lane & 31) * 4 + (lane >> 5) * 2) = (unsigned short)scb;
        }
    }
}

template <int NPART, bool XB> DI void norm_rows(const Frame& F, const void* xpv, const void* xsv, const float* nw, const float* modl, int sh_off, int sc_off) {
    const int tid = fresh_tid(F.wave), lane = tid & 63, wave = __builtin_amdgcn_readfirstlane(tid >> 6);
    for (int row = blockIdx.x * 8 + wave; row < NTOK; row += gridDim.x * 8) {
        const float* x = (row < TP) ? (const float*)xpv + (size_t)row * D : (const float*)xsv + (size_t)(row - TP) * D;
        const bf16_t* xb = (row < TP) ? (const bf16_t*)xpv + (size_t)row * D : (const bf16_t*)xsv + (size_t)(row - TP) * D;
        const int grp = (row < TP) ? 0 : 1 + ((row - TP) >> 11);
        const float* md = modl + (size_t)grp * 12288;
        f32x4 v[8]; float ss = 0.f;
#pragma unroll
        for (int j = 0; j < 8; ++j) { if (XB) { const u32x2 w = *(const u32x2*)(xb + j * 256 + lane * 4); v[j] = (f32x4){bf_lo(w.x), bf_hi(w.x), bf_lo(w.y), bf_hi(w.y)}; } else v[j] = *(const f32x4*)(x + j * 256 + lane * 4); ss += v[j][0] * v[j][0] + v[j][1] * v[j][1] + v[j][2] * v[j][2] + v[j][3] * v[j][3]; }
        ss = wave_sum(ss);
        const float rstd = __frsqrt_rn(ss * (1.0f / 2048.0f) + EPS);
#pragma unroll
        for (int j = 0; j < 8; ++j) { const int cidx = j * 256 + lane * 4;
            const f32x4 w = *(const f32x4*)(nw + cidx); f32x4 sc = *(const f32x4*)(md + sc_off + cidx), sh = *(const f32x4*)(md + sh_off + cidx);
#pragma unroll
            for (int p = 1; p < NPART; ++p) { sc += *(const f32x4*)(md + p * MODP_STRIDE + sc_off + cidx); sh += *(const f32x4*)(md + p * MODP_STRIDE + sh_off + cidx); }
            const f32x4 h = v[j] * rstd * w * (1.0f + sc) + sh;
            u32x2 o = {pk_bf16(h[0], h[1]), pk_bf16(h[2], h[3])};
            *(u32x2*)(F.HB + (size_t)row * D + cidx) = o; }
    }
}

constexpr int SC_QT = 0, SC_KH = 8704, SC_KT = 17408, SC_VT = 27648, SC_EB = 37888, SC_BUF = 38400;
DI bf16x8 pack8(const f32x16& x, const int s) {
    u32x4 p = {pk_bf16(x[8 * s], x[8 * s + 1]), pk_bf16(x[8 * s + 2], x[8 * s + 3]), pk_bf16(x[8 * s + 4], x[8 * s + 5]), pk_bf16(x[8 * s + 6], x[8 * s + 7])};
    return __builtin_bit_cast(bf16x8, p);
}
DI bf16x8 lds_2x8(const LAS unsigned char* p) {
    const u32x2 a = *(const LAS u32x2*)p, b = *(const LAS u32x2*)(p + 16);
    u32x4 r = {a[0], a[1], b[0], b[1]}; return __builtin_bit_cast(bf16x8, r);
}
DI void p3_scan(const Frame& F, const int l) {
    const int b = blockIdx.x; if (b >= 256) return;
    int tok0, T, bseq, h, cbeg; bool sample;
    if (b < 128) { sample = false; bseq = b >> 3; h = b & 7; T = 256; tok0 = bseq * 256; cbeg = 0; }
    else { sample = true; const int ix = b - 128; bseq = ix >> 6; cbeg = ((ix >> 3) & 7) * 8; h = ix & 7; T = 2048; tok0 = TP + bseq * 2048; }
    const int tid = fresh_tid(F.wave), lane = tid & 63, wave = __builtin_amdgcn_readfirstlane(tid >> 6);
    const int dir = wave >> 2, wv = wave & 3, r = lane & 31, hh = lane >> 5;
    LAS unsigned char* gbase = F.lds + dir * (2 * SC_BUF);
    const int cp = lane & 15, tg = lane >> 4, ch0 = 32 * wv + 2 * cp;
    const float lb0 = F.LB[(dir * 4 + l) * 1024 + h * 128 + ch0], lb1 = F.LB[(dir * 4 + l) * 1024 + h * 128 + ch0 + 1];
    const float om0 = 1.f - lb0, om1 = 1.f - lb1;
    const bf16_t* pcol = F.P + h * 128 + ch0;
    const int zoff = 1024 * (1 + dir);
    bf16_t* obuf = (dir ? F.OB : F.OF) + h * 128 + 32 * wv + r;
    f32x16 S[4];
#pragma unroll
    for (int mb = 0; mb < 4; ++mb)
#pragma unroll
        for (int i = 0; i < 16; ++i) S[mb][i] = 0.f;
    float bprev0 = 0.f, bprev1 = 0.f;
    unsigned qq[8], zz[8], vv[8], qn[8], zn[8], vn[8];
#pragma unroll
    for (int j = 0; j < 8; ++j) { int pos = cbeg * 32 + 8 * tg + j; if (dir) pos = T - 1 - pos; const bf16_t* rowp = pcol + (size_t)(tok0 + pos) * DIN;
        qq[j] = *(const unsigned*)rowp; zz[j] = *(const unsigned*)(rowp + zoff); vv[j] = *(const unsigned*)(rowp + 3072); }
#pragma unroll
    for (int j = 0; j < 8; ++j) { int pos = (cbeg + 1) * 32 + 8 * tg + j; if (dir) pos = T - 1 - pos; const bf16_t* rowp = pcol + (size_t)(tok0 + pos) * DIN;
        qn[j] = *(const unsigned*)rowp; zn[j] = *(const unsigned*)(rowp + zoff); vn[j] = *(const unsigned*)(rowp + 3072); }
    const float scale = 0.08838834764831845f;
    for (int c = cbeg; c < cbeg + 8; ++c) {
        LAS unsigned char* buf = gbase + (c & 1) * SC_BUF;
        {
            float bc0[8], bc1[8], k0[8], k1[8]; float run0 = 0.f, run1 = 0.f;
#pragma unroll
            for (int j = 0; j < 8; ++j) {
                const float z0 = fmaxf(bf_lo(zz[j]), -80.f), z1 = fmaxf(bf_hi(zz[j]), -80.f);
                const float e0 = __expf(-z0), e1 = __expf(-z1);
                const float s0 = __builtin_amdgcn_rcpf(1.f + e0), s1 = __builtin_amdgcn_rcpf(1.f + e1);
                const float f0 = lb0 + om0 * s0, f1 = lb1 + om1 * s1;
                k0[j] = om0 * e0 * s0; k1[j] = om1 * e1 * s1;
                run0 += __logf(f0); run1 += __logf(f1); bc0[j] = run0; bc1[j] = run1;
            }
#define LANE_GET(v, ln) __int_as_float(__builtin_amdgcn_ds_bpermute((ln) << 2, __float_as_int(v)))
            const float a00 = LANE_GET(run0, cp), a01 = LANE_GET(run0, cp + 16), a02 = LANE_GET(run0, cp + 32), a03 = LANE_GET(run0, cp + 48);
            const float a10 = LANE_GET(run1, cp), a11 = LANE_GET(run1, cp + 16), a12 = LANE_GET(run1, cp + 32), a13 = LANE_GET(run1, cp + 48);
#undef LANE_GET
            const float off0 = (tg > 0 ? a00 : 0.f) + (tg > 1 ? a01 : 0.f) + (tg > 2 ? a02 : 0.f);
            const float off1 = (tg > 0 ? a10 : 0.f) + (tg > 1 ? a11 : 0.f) + (tg > 2 ? a12 : 0.f);
            unsigned kt0[4], kt1[4], vt0[4], vt1[4]; float kh0[8], kh1[8];
            const float ep0 = __expf(bprev0), ep1 = __expf(bprev1);
#pragma unroll
            for (int j = 0; j < 8; ++j) {
                const float B0 = off0 + bc0[j], B1 = off1 + bc1[j];
                const float eq0 = __expf(B0), eq1 = __expf(B1), ek0 = __expf(fminf(-B0, 85.f)), ek1 = __expf(fminf(-B1, 85.f));
                const float qt0 = bf_lo(qq[j]) * eq0, qt1 = bf_hi(qq[j]) * eq1;
                kh0[j] = k0[j] * ek0; kh1[j] = k1[j] * ek1;
                const int rr = 8 * tg + j;
                *(LAS unsigned*)(buf + SC_QT + rr * 272 + ch0 * 2) = pk_bf16(qt0, qt1);
                *(LAS unsigned*)(buf + SC_KH + rr * 272 + ch0 * 2) = pk_bf16(kh0[j], kh1[j]);
                if (sample) { int pos = c * 32 + rr; if (dir) pos = T - 1 - pos;
                    *(unsigned*)(F.QH + ((size_t)dir * 4096 + bseq * 2048 + pos) * 1024 + h * 128 + ch0) = pk_bf16(qt0 * ep0, qt1 * ep1); }
            }
#pragma unroll
            for (int j = 0; j < 4; ++j) { kt0[j] = pk_bf16(kh0[2 * j], kh0[2 * j + 1]); kt1[j] = pk_bf16(kh1[2 * j], kh1[2 * j + 1]);
                vt0[j] = (vv[2 * j] & 0xffffu) | (vv[2 * j + 1] << 16); vt1[j] = (vv[2 * j] >> 16) | (vv[2 * j + 1] & 0xffff0000u); }
            *(LAS u32x4*)(buf + SC_KT + ch0 * 80 + 16 * tg) = (u32x4){kt0[0], kt0[1], kt0[2], kt0[3]};
            *(LAS u32x4*)(buf + SC_KT + (ch0 + 1) * 80 + 16 * tg) = (u32x4){kt1[0], kt1[1], kt1[2], kt1[3]};
            *(LAS u32x4*)(buf + SC_VT + ch0 * 80 + 16 * tg) = (u32x4){vt0[0], vt0[1], vt0[2], vt0[3]};
            *(LAS u32x4*)(buf + SC_VT + (ch0 + 1) * 80 + 16 * tg) = (u32x4){vt1[0], vt1[1], vt1[2], vt1[3]};
            const float t0 = a00 + a01 + a02 + a03, t1 = a10 + a11 + a12 + a13; bprev0 += t0; bprev1 += t1;
            if (tg == 0) *(LAS f32x2*)(buf + SC_EB + ch0 * 4) = (f32x2){__expf(t0), __expf(t1)};
        }
#pragma unroll
        for (int j = 0; j < 8; ++j) { qq[j] = qn[j]; zz[j] = zn[j]; vv[j] = vn[j]; }
        if (c + 2 < cbeg + 8) {
#pragma unroll
            for (int j = 0; j < 8; ++j) { int pos = (c + 2) * 32 + 8 * tg + j; if (dir) pos = T - 1 - pos; const bf16_t* rowp = pcol + (size_t)(tok0 + pos) * DIN;
                qn[j] = *(const unsigned*)rowp; zn[j] = *(const unsigned*)(rowp + zoff); vn[j] = *(const unsigned*)(rowp + 3072); }
        }
        __syncthreads();
        f32x16 Pm;
#pragma unroll
        for (int i = 0; i < 16; ++i) Pm[i] = 0.f;
#pragma unroll
        for (int ks = 0; ks < 8; ++ks) {
            const bf16x8 a = *(const LAS bf16x8*)(buf + SC_KH + r * 272 + (16 * ks + 8 * hh) * 2);
            const bf16x8 bq = *(const LAS bf16x8*)(buf + SC_QT + r * 272 + (16 * ks + 8 * hh) * 2);
            Pm = MFMA32(a, bq, Pm);
        }
#pragma unroll
        for (int i = 0; i < 16; ++i) Pm[i] = (crow(i, hh) <= r) ? Pm[i] : 0.f;
        f32x16 O;
#pragma unroll
        for (int i = 0; i < 16; ++i) O[i] = 0.f;
#pragma unroll
        for (int mb = 0; mb < 4; ++mb)
#pragma unroll
            for (int s2 = 0; s2 < 2; ++s2) {
                const bf16x8 a = lds_2x8(buf + SC_QT + r * 272 + (32 * mb + 16 * s2 + 4 * hh) * 2);
                O = MFMA32(a, pack8(S[mb], s2), O);
            }
#pragma unroll
        for (int s2 = 0; s2 < 2; ++s2) {
            const bf16x8 bv = lds_2x8(buf + SC_VT + (32 * wv + r) * 80 + (16 * s2 + 4 * hh) * 2);
            O = MFMA32(pack8(Pm, s2), bv, O);
        }
#pragma unroll
        for (int mb = 0; mb < 4; ++mb) {
#pragma unroll
            for (int ks = 0; ks < 2; ++ks) {
                const bf16x8 a = *(const LAS bf16x8*)(buf + SC_KT + (32 * mb + r) * 80 + (16 * ks + 8 * hh) * 2);
                const bf16x8 bv = *(const LAS bf16x8*)(buf + SC_VT + (32 * wv + r) * 80 + (16 * ks + 8 * hh) * 2);
                S[mb] = MFMA32(a, bv, S[mb]);
            }
#pragma unroll
            for (int q4 = 0; q4 < 4; ++q4) { const f32x4 e = *(const LAS f32x4*)(buf + SC_EB + (32 * mb + 8 * q4 + 4 * hh) * 4);
#pragma unroll
                for (int j = 0; j < 4; ++j) S[mb][4 * q4 + j] *= e[j]; }
        }
#pragma unroll
        for (int i = 0; i < 16; ++i) { int pos = c * 32 + crow(i, hh); if (dir) pos = T - 1 - pos; const float ov_ = O[i] * scale, on_ = xshfl<1>(ov_); if (!(r & 1)) *(unsigned*)(obuf + (size_t)(tok0 + pos) * 1024) = pk_bf16(ov_, on_); }
    }
    float* so;
    if (!sample) so = F.out + (size_t)NTOK * D + ((size_t)((bseq * 4 + l) * 2 + dir) * 8 + h) * 16384 + 32 * wv + r;
    else { const int u = ((bseq * 2 + dir) * 8 + h) * 8 + (cbeg >> 3); so = F.SSEG + (size_t)u * 16384 + 32 * wv + r;
        if (tg == 0) *(f32x2*)(F.DSEG + (size_t)u * 128 + ch0) = (f32x2){__expf(bprev0), __expf(bprev1)}; }
#pragma unroll
    for (int mb = 0; mb < 4; ++mb)
#pragma unroll
        for (int i = 0; i < 16; ++i) so[(32 * mb + crow(i, hh)) * 128] = S[mb][i];
}

DI void p3c_correct(const Frame& F, const int l) {
    const int u = blockIdx.x; if (u >= 256) return;
    const int tid = fresh_tid(F.wave), lane = tid & 63, wave = __builtin_amdgcn_readfirstlane(tid >> 6), r = lane & 31, hh = lane >> 5;
    const int sseq = u >> 7, dir = (u >> 6) & 1, h = (u >> 3) & 7, seg = u & 7, ub = u - seg;
    {
        const int v = tid & 127, kq = tid >> 7;
        const float* st0 = F.state_in + ((size_t)((sseq * 4 + l) * 2 + dir) * 8 + h) * 16384 + v;
        float val[32];
#pragma unroll
        for (int kk = 0; kk < 32; ++kk) val[kk] = st0[(kq * 32 + kk) * 128];
        for (int j = 0; j < seg; ++j) { const float* sp = F.SSEG + (size_t)(ub + j) * 16384 + v; const float* dp = F.DSEG + (size_t)(ub + j) * 128;
#pragma unroll
            for (int kk = 0; kk < 32; ++kk) val[kk] = dp[kq * 32 + kk] * val[kk] + sp[(kq * 32 + kk) * 128]; }
#pragma unroll
        for (int g = 0; g < 4; ++g)
            *(LAS u32x4*)(F.lds + v * 272 + (kq * 32 + 8 * g) * 2) = (u32x4){pk_bf16(val[8 * g], val[8 * g + 1]), pk_bf16(val[8 * g + 2], val[8 * g + 3]), pk_bf16(val[8 * g + 4], val[8 * g + 5]), pk_bf16(val[8 * g + 6], val[8 * g + 7])};
    }
    __syncthreads();
    int posr = seg * 256 + 32 * wave + r; if (dir) posr = 2047 - posr;
    const bf16_t* qp = F.QH + ((size_t)dir * 4096 + sseq * 2048 + posr) * 1024 + h * 128 + 8 * hh;
    bf16x8 a[8];
#pragma unroll
    for (int ks = 0; ks < 8; ++ks) a[ks] = *(const bf16x8*)(qp + 16 * ks);
    bf16_t* ob = (dir ? F.OB : F.OF) + (size_t)(TP + sseq * 2048) * 1024 + h * 128 + r;
    const float scale = 0.08838834764831845f;
#pragma unroll
    for (int nb = 0; nb < 4; ++nb) {
        f32x16 acc;
#pragma unroll
        for (int i = 0; i < 16; ++i) acc[i] = 0.f;
#pragma unroll
        for (int ks = 0; ks < 8; ++ks) { const bf16x8 bv = *(const LAS bf16x8*)(F.lds + (32 * nb + r) * 272 + (16 * ks + 8 * hh) * 2); acc = MFMA32(a[ks], bv, acc); }
#pragma unroll
        for (int i = 0; i < 16; ++i) { int pos = seg * 256 + 32 * wave + crow(i, hh); if (dir) pos = 2047 - pos; const float cv_ = scale * acc[i], cn_ = xshfl<1>(cv_); if (!(r & 1)) { unsigned* op = (unsigned*)(ob + (size_t)pos * 1024 + 32 * nb); const unsigned w_ = *op; *op = pk_bf16(bf_lo(w_) + cv_, bf_hi(w_) + cn_); } }
    }
}

DI void p4_combine(const Frame& F, const int l) {
    const int tid = fresh_tid(F.wave), lane = tid & 63, wave = __builtin_amdgcn_readfirstlane(tid >> 6), c0 = lane * 16;
    for (int tok = blockIdx.x * 8 + wave; tok < NTOK; tok += gridDim.x * 8) {
        {
            const bf16_t* pf = F.OF + (size_t)tok * 1024 + c0; const bf16_t* pb = F.OB + (size_t)tok * 1024 + c0;
            const u32x4 f0 = *(const u32x4*)pf, f1 = *(const u32x4*)(pf + 8), b0 = *(const u32x4*)pb, b1 = *(const u32x4*)(pb + 8);
            f32x4 o[4]; float ss = 0.f;
#pragma unroll
            for (int j = 0; j < 4; ++j) { const unsigned fa = (j < 2) ? f0[2 * j] : f1[2 * j - 4], fb = (j < 2) ? f0[2 * j + 1] : f1[2 * j - 3], ba = (j < 2) ? b0[2 * j] : b1[2 * j - 4], bb = (j < 2) ? b0[2 * j + 1] : b1[2 * j - 3];
                o[j] = (f32x4){bf_lo(fa) + bf_lo(ba), bf_hi(fa) + bf_hi(ba), bf_lo(fb) + bf_lo(bb), bf_hi(fb) + bf_hi(bb)}; ss += o[j][0] * o[j][0] + o[j][1] * o[j][1] + o[j][2] * o[j][2] + o[j][3] * o[j][3]; }
            ss += xshfl<1>(ss); ss += xshfl<2>(ss); ss += xshfl<4>(ss);
            const float rstd = __frsqrt_rn(ss * (1.0f / 128.0f) + EPS);
            const u32x4 g0 = *(const u32x4*)(F.P + (size_t)tok * DIN + 4096 + c0), g1 = *(const u32x4*)(F.P + (size_t)tok * DIN + 4096 + c0 + 8);
            const float* gw = F.hgrn_norm_w + l * 1024 + c0;
            unsigned w[8];
#pragma unroll
            for (int j = 0; j < 4; ++j) { const f32x4 gn = *(const f32x4*)(gw + 4 * j); const unsigned ga = (j < 2) ? g0[2 * j] : g1[2 * j - 4], gb = (j < 2) ? g0[2 * j + 1] : g1[2 * j - 3];
                const float r0 = o[j][0] * rstd * gn[0] * silu_f(bf_lo(ga)), r1 = o[j][1] * rstd * gn[1] * silu_f(bf_hi(ga));
                const float r2 = o[j][2] * rstd * gn[2] * silu_f(bf_lo(gb)), r3 = o[j][3] * rstd * gn[3] * silu_f(bf_hi(gb));
                w[2 * j] = pk_bf16(r0, r1); w[2 * j + 1] = pk_bf16(r2, r3); }
            bf16_t* dst = F.CAT + (size_t)tok * D + c0;
            *(u32x4*)dst = (u32x4){w[0], w[1], w[2], w[3]}; *(u32x4*)(dst + 8) = (u32x4){w[4], w[5], w[6], w[7]};
        }
        {
            const int gi = lane >> 4, half = 1 << gi;
            int L, pos; if (tok < TP) { L = 256; pos = tok & 255; } else { L = 64; pos = (tok - TP) & 63; }
            const int sbase = tok - pos; int lo = pos - half; lo = lo < 0 ? 0 : lo; int hi = pos + half; hi = hi > L ? L : hi;
            float acc[16];
#pragma unroll
            for (int j = 0; j < 16; ++j) acc[j] = 0.f;
            const bf16_t* pu = F.P + 5120 + c0;
            for (int d0 = -half; d0 < half; d0 += 4) {
                u32x4 a[4], bq[4]; float mk[4];
#pragma unroll
                for (int u = 0; u < 4; ++u) { const int d = d0 + u, t = pos + d; const bool ok = (d < half) && (t >= 0) && (t < L); const int tt = ok ? t : pos; mk[u] = ok ? 1.f : 0.f;
                    a[u] = *(const u32x4*)(pu + (size_t)(sbase + tt) * DIN); bq[u] = *(const u32x4*)(pu + (size_t)(sbase + tt) * DIN + 8); }
#pragma unroll
                for (int u = 0; u < 4; ++u)
#pragma unroll
                    for (int j = 0; j < 4; ++j) { acc[2 * j] += mk[u] * bf_lo(a[u][j]); acc[2 * j + 1] += mk[u] * bf_hi(a[u][j]); acc[8 + 2 * j] += mk[u] * bf_lo(bq[u][j]); acc[9 + 2 * j] += mk[u] * bf_hi(bq[u][j]); } }
            const float inv = 1.0f / (float)(hi - lo);
            const u32x4 sa = *(const u32x4*)(pu + (size_t)tok * DIN), sb = *(const u32x4*)(pu + (size_t)tok * DIN + 8);
            const float* ps = F.pool_scale + l * 1024 + c0;
            unsigned w[8];
#pragma unroll
            for (int j = 0; j < 4; ++j) { const f32x4 s0 = *(const f32x4*)(ps + 4 * j);
                const unsigned ua = (j < 2) ? sa[2 * j] : sb[2 * j - 4], ub = (j < 2) ? sa[2 * j + 1] : sb[2 * j - 3];
                const float r0 = (acc[4 * j] * inv - bf_lo(ua)) * s0[0], r1 = (acc[4 * j + 1] * inv - bf_hi(ua)) * s0[1];
                const float r2 = (acc[4 * j + 2] * inv - bf_lo(ub)) * s0[2], r3 = (acc[4 * j + 3] * inv - bf_hi(ub)) * s0[3];
                w[2 * j] = pk_bf16(r0, r1); w[2 * j + 1] = pk_bf16(r2, r3); }
            bf16_t* dst = F.CAT + (size_t)tok * D + 1024 + c0;
            *(u32x4*)dst = (u32x4){w[0], w[1], w[2], w[3]}; *(u32x4*)(dst + 8) = (u32x4){w[4], w[5], w[6], w[7]};
        }
    }
}

#define CE_D(a, b) do { const float _h = fmaxf(a, b), _l = fminf(a, b); a = _h; b = _l; } while (0)
#define CE_A(a, b) do { const float _h = fmaxf(a, b), _l = fminf(a, b); a = _l; b = _h; } while (0)
template <int N> DI void bitonic_sort_desc(float* v) {
#pragma unroll
    for (int k = 2; k <= N; k <<= 1)
#pragma unroll
        for (int j = k >> 1; j > 0; j >>= 1)
#pragma unroll
            for (int i = 0; i < N; ++i) { const int x = i ^ j; if (x > i) { if ((i & k) == 0) CE_D(v[i], v[x]); else CE_A(v[i], v[x]); } }
}
template <int N> DI void bitonic_merge_desc(float* v) {
#pragma unroll
    for (int j = N >> 1; j > 0; j >>= 1)
#pragma unroll
        for (int i = 0; i < N; ++i) { const int x = i ^ j; if (x > i) CE_D(v[i], v[x]); }
}
#define CEP_D(ka, kb, pa, pb) do { const bool _s = (kb) > (ka); const float _k = _s ? (kb) : (ka); kb = _s ? (ka) : (kb); ka = _k; const unsigned _p = _s ? (pb) : (pa); pb = _s ? (pa) : (pb); pa = _p; } while (0)
#define CEP_A(ka, kb, pa, pb) do { const bool _s = (kb) < (ka); const float _k = _s ? (kb) : (ka); kb = _s ? (ka) : (kb); ka = _k; const unsigned _p = _s ? (pb) : (pa); pb = _s ? (pa) : (pb); pa = _p; } while (0)
template <int N> DI void bitonic_sort_desc_p(float* v, unsigned* p) {
#pragma unroll
    for (int k = 2; k <= N; k <<= 1)
#pragma unroll
        for (int j = k >> 1; j > 0; j >>= 1)
#pragma unroll
            for (int i = 0; i < N; ++i) { const int x = i ^ j; if (x > i) { if ((i & k) == 0) CEP_D(v[i], v[x], p[i], p[x]); else CEP_A(v[i], v[x], p[i], p[x]); } }
}
template <int N> DI void bitonic_merge_desc_p(float* v, unsigned* p) {
#pragma unroll
    for (int j = N >> 1; j > 0; j >>= 1)
#pragma unroll
        for (int i = 0; i < N; ++i) { const int x = i ^ j; if (x > i) CEP_D(v[i], v[x], p[i], p[x]); }
}
DI void p8_topk(const Frame& F, const int l, const pg8::StaticOrder& S) {
    const int tid = fresh_tid(F.wave), lane = tid & 63, wave = __builtin_amdgcn_readfirstlane(tid >> 6), r = lane & 31, hh = lane >> 5;
    pg8::Unit u;
    for (int ui = 0; S.next(ui, u); ++ui) {
        const int tile = u.pm * 8 + wave, h = u.pn; const int tok = tile * 32 + r;
        float s1[16], s2[16];
#pragma unroll 1
        for (int p = 0; p < 2; ++p) {
            const bf16_t* qrow = F.Q + (size_t)tok * D + h * 256 + p * 128 + 8 * hh;
            bf16x8 bq[8];
#pragma unroll
            for (int ks = 0; ks < 8; ++ks) bq[ks] = *(const bf16x8*)(qrow + 16 * ks);
            const bf16_t* kb = F.KEYS + ((size_t)((l * 8 + h) * 2 + p) * 128) * 128 + 8 * hh;
            float best[16];
#pragma unroll
            for (int i = 0; i < 16; ++i) best[i] = -INFINITY;
#pragma unroll 1
            for (int mb = 0; mb < 4; ++mb) {
                f32x16 acc;
#pragma unroll
                for (int i = 0; i < 16; ++i) acc[i] = 0.f;
#pragma unroll
                for (int ks = 0; ks < 8; ++ks) { const bf16x8 a = *(const bf16x8*)(kb + (size_t)(32 * mb + r) * 128 + 16 * ks); acc = MFMA32(a, bq[ks], acc); }
                float sc[16];
#pragma unroll
                for (int i = 0; i < 16; ++i) sc[i] = __uint_as_float((__float_as_uint(acc[i]) & ~127u) | (unsigned)(32 * mb + crow(i, hh)));
                bitonic_sort_desc<16>(sc);
#pragma unroll
                for (int i = 0; i < 16; ++i) best[i] = fmaxf(best[i], sc[15 - i]);
                bitonic_merge_desc<16>(best);
            }
            float pbv[16];
#pragma unroll
            for (int i = 0; i < 16; ++i) pbv[i] = xshfl<32>(best[i]);
#pragma unroll
            for (int i = 0; i < 16; ++i) best[i] = fmaxf(best[i], pbv[15 - i]);
            bitonic_merge_desc<16>(best);
            if (p == 0) {
#pragma unroll
                for (int i = 0; i < 16; ++i) s1[i] = best[i];
            } else {
#pragma unroll
                for (int i = 0; i < 16; ++i) s2[i] = best[i];
            }
        }
        float ca[16], cb[16]; unsigned ia[16], ib[16];
        const unsigned sha = hh ? 0u : 7u, shb = hh ? 7u : 0u;
#pragma unroll
        for (int i = 0; i < 16; ++i) { ca[i] = hh ? s2[i] : s1[i]; cb[i] = hh ? s1[i] : s2[i];
            ia[i] = (__float_as_uint(ca[i]) & 127u) << sha; ib[i] = (__float_as_uint(cb[i]) & 127u) << shb; }
        float cs[32]; unsigned cid[32];
        {
            int n = 0;
#pragma unroll
            for (int i = 0; i < 4; ++i)
#pragma unroll
                for (int j = i; j < 16; ++j) if ((i + 1) * (j + 1) <= 16) { float sv = ca[i] + cb[j]; if (i == j && hh) sv = -INFINITY; cs[n] = sv; cid[n] = ia[i] | ib[j]; ++n; }
#pragma unroll
            for (; n < 32; ++n) { cs[n] = -INFINITY; cid[n] = 0u; }
        }
        float tk[16]; unsigned ti[16];
#pragma unroll
        for (int i = 0; i < 16; ++i) { tk[i] = -INFINITY; ti[i] = 0u; }
#pragma unroll 1
        for (int it = 0; it < 2; ++it) {
            float ck[16]; unsigned ci[16];
#pragma unroll
            for (int i = 0; i < 16; ++i) { ck[i] = it ? cs[16 + i] : cs[i]; ci[i] = it ? cid[16 + i] : cid[i]; }
            bitonic_sort_desc_p<16>(ck, ci);
#pragma unroll
            for (int i = 0; i < 16; ++i) { const bool sw = ck[15 - i] > tk[i]; tk[i] = sw ? ck[15 - i] : tk[i]; ti[i] = sw ? ci[15 - i] : ti[i]; }
            bitonic_merge_desc_p<16>(tk, ti);
        }
        float pk_[16]; unsigned pi_[16];
#pragma unroll
        for (int i = 0; i < 16; ++i) { pk_[i] = xshfl<32>(tk[i]); pi_[i] = __float_as_uint(xshfl<32>(__uint_as_float(ti[i]))); }
        float fk[16]; unsigned fi[16]; float mx = -INFINITY;
#pragma unroll
        for (int i = 0; i < 16; ++i) { const bool sw = pk_[15 - i] > tk[i]; fk[i] = sw ? pk_[15 - i] : tk[i]; fi[i] = sw ? pi_[15 - i] : ti[i]; mx = fmaxf(mx, fk[i]); }
        float z = 0.f;
#pragma unroll
        for (int i = 0; i < 16; ++i) { fk[i] = __expf(fk[i] - mx); z += fk[i]; }
        const float iz = 1.0f / z;
        int* di = F.SELI + (size_t)tok * 128 + h * 16 + hh * 8; float* dg = F.SELG + (size_t)tok * 128 + h * 16 + hh * 8;
        *(u32x4*)di = (u32x4){fi[0], fi[1], fi[2], fi[3]}; *(u32x4*)(di + 4) = (u32x4){fi[4], fi[5], fi[6], fi[7]};
        *(f32x4*)dg = (f32x4){fk[0] * iz, fk[1] * iz, fk[2] * iz, fk[3] * iz}; *(f32x4*)(dg + 4) = (f32x4){fk[4] * iz, fk[5] * iz, fk[6] * iz, fk[7] * iz};
    }
}

constexpr int NB = 4;
DI float reduce8(const float (&p)[8], const int lane) {
    const bool b5 = lane & 32, b4 = lane & 16, b3 = lane & 8;
    float k4[4], k2[2];
#pragma unroll
    for (int i = 0; i < 4; ++i) { const float snd = b5 ? p[i] : p[i + 4], kp = b5 ? p[i + 4] : p[i]; k4[i] = kp + xshfl<32>(snd); }
#pragma unroll
    for (int i = 0; i < 2; ++i) { const float snd = b4 ? k4[i] : k4[i + 2], kp = b4 ? k4[i + 2] : k4[i]; k2[i] = kp + xshfl<16>(snd); }
    const float snd = b3 ? k2[0] : k2[1], kp = b3 ? k2[1] : k2[0];
    float t = kp + xshfl<8>(snd);
    t += xshfl<4>(t); t += xshfl<2>(t); t += xshfl<1>(t);
    return t;
}
#define CVT8(x, hi) __builtin_amdgcn_cvt_pk_f32_fp8((x), (hi))
constexpr int NT = 2;
DI float half_sum(float v) { v += xshfl<16>(v); v += xshfl<8>(v); v += xshfl<4>(v); v += xshfl<2>(v); v += xshfl<1>(v); return v; }
DI float half_max(float v) { v = fmaxf(v, xshfl<16>(v)); v = fmaxf(v, xshfl<8>(v)); v = fmaxf(v, xshfl<4>(v)); v = fmaxf(v, xshfl<2>(v)); v = fmaxf(v, xshfl<1>(v)); return v; }
DI float reduce8h(const float (&p)[8], const int lane) {
    const bool b4 = lane & 16, b3 = lane & 8, b2 = lane & 4;
    float k4[4], k2[2];
#pragma unroll
    for (int i = 0; i < 4; ++i) { const float snd = b4 ? p[i] : p[i + 4], kp = b4 ? p[i + 4] : p[i]; k4[i] = kp + xshfl<16>(snd); }
#pragma unroll
    for (int i = 0; i < 2; ++i) { const float snd = b3 ? k4[i] : k4[i + 2], kp = b3 ? k4[i + 2] : k4[i]; k2[i] = kp + xshfl<8>(snd); }
    const float snd = b2 ? k2[0] : k2[1], kp = b2 ? k2[1] : k2[0];
    float t = kp + xshfl<4>(snd);
    t += xshfl<2>(t); t += xshfl<1>(t);
    return t;
}
struct RowH { u32x4 d[2]; unsigned s; };
DI h32v blk_decode(const RowH& r, const int t) { h32v e;
#pragma unroll
    for (int dd = 0; dd < 4; ++dd)
        { const unsigned w = r.d[t][dd];
          const h2v v0 = __builtin_amdgcn_cvt_scalef32_pk_f16_fp4(w, 1.0f, 0), v1 = __builtin_amdgcn_cvt_scalef32_pk_f16_fp4(w, 1.0f, 1), v2 = __builtin_amdgcn_cvt_scalef32_pk_f16_fp4(w, 1.0f, 2), v3 = __builtin_amdgcn_cvt_scalef32_pk_f16_fp4(w, 1.0f, 3);
          e[8 * dd] = v0.x; e[8 * dd + 1] = v0.y; e[8 * dd + 2] = v1.x; e[8 * dd + 3] = v1.y; e[8 * dd + 4] = v2.x; e[8 * dd + 5] = v2.y; e[8 * dd + 6] = v3.x; e[8 * dd + 7] = v3.y; }
    return e; }
DI float blk_scale(const RowH& r, const int t) { return t ? __uint_as_float(r.s & 0xffff0000u) : __uint_as_float(r.s << 16); }
DI float dot64(const RowH& r, const h2v (&hv)[32]) {
    float tot = 0.f;
#pragma unroll
    for (int t = 0; t < 2; ++t) { const h32v e = blk_decode(r, t); float acc = 0.f;
#pragma unroll
        for (int p = 0; p < 16; ++p) acc = __builtin_amdgcn_fdot2((h2v){e[2 * p], e[2 * p + 1]}, hv[t * 16 + p], acc, false);
        tot += acc * blk_scale(r, t); }
    return tot;
}
DI float dot64i(const RowH& r, const int (&hh)[8], const int (&hl)[8], const float (&shs)[2]) {
    float tot = 0.f;
#pragma unroll
    for (int t = 0; t < 2; ++t) { int ah = 0, al = 0;
#pragma unroll
        for (int dd = 0; dd < 4; ++dd) { ah = __builtin_amdgcn_sdot8((int)r.d[t][dd], hh[t * 4 + dd], ah, false); al = __builtin_amdgcn_sdot8((int)r.d[t][dd], hl[t * 4 + dd], al, false); }
        tot += (float)(ah * 16 + al) * (blk_scale(r, t) * shs[t]); }
    return tot;
}
DI void axpy64(const RowH& r, h2v (&ov)[32], const float w) {
#pragma unroll
    for (int t = 0; t < 2; ++t) { const h32v e = blk_decode(r, t); const _Float16 ws = (_Float16)(w * blk_scale(r, t)); const h2v wv = {ws, ws};
#pragma unroll
        for (int p = 0; p < 16; ++p) ov[t * 16 + p] += (h2v){e[2 * p], e[2 * p + 1]} * wv; }
}
DI void p9_peer(const Frame& F, const int l) {
    const int tid = fresh_tid(F.wave), lane = tid & 63, wave = __builtin_amdgcn_readfirstlane(tid >> 6);
    const unsigned char* UTu = F.UTAB + (size_t)l * NEXP * ROWB; const unsigned char* VTu = F.VTAB + (size_t)l * NEXP * ROWB;
    for (int tokb = (blockIdx.x * 8 + wave) * NT; tokb < NTOK; tokb += gridDim.x * 8 * NT) {
        int lnn = lane; asm volatile("; addresses of this token pair are rebuilt here, not hoisted" : "+v"(lnn));
        const int half = lnn >> 5, lq = lnn & 31;
        LAS unsigned* listw = (LAS unsigned*)(F.lds + wave * 3072 + half * 512);
        LAS float* listg = (LAS float*)(F.lds + wave * 3072 + 1024 + half * 512);
        LAS float* actl = (LAS float*)(F.lds + wave * 3072 + 2048 + half * 512);
        const int tok = tokb + half;
        {
            LAS unsigned* keyl = (LAS unsigned*)actl;
            unsigned key[4]; float gg[4]; unsigned rk[4];
#pragma unroll
            for (int r = 0; r < 4; ++r) { const size_t ei = (size_t)tok * 128 + r * 32 + lq; key[r] = ((unsigned)F.SELI[ei] << 7) | (unsigned)(r * 32 + lq); gg[r] = F.SELG[ei]; keyl[r * 32 + lq] = key[r]; rk[r] = 0u; }
#pragma unroll 1
            for (int j = 0; j < 128; j += 4) { const u32x4 kk = *(const LAS u32x4*)(keyl + j);
#pragma unroll
                for (int q = 0; q < 4; ++q)
#pragma unroll
                    for (int r = 0; r < 4; ++r) rk[r] += (kk[q] < key[r]) ? 1u : 0u; }
#pragma unroll
            for (int r = 0; r < 4; ++r) { listw[rk[r]] = key[r] >> 7; listg[rk[r]] = gg[r]; }
        }
#define H_LOAD(buf, TABu, idv) do { const unsigned char* rp_ = TABu + (size_t)(idv) * ROWB; buf.d[0] = *(const u32x4*)(rp_ + lq * 32); buf.d[1] = *(const u32x4*)(rp_ + lq * 32 + 16); buf.s = *(const unsigned*)(rp_ + 1024 + lq * 4); } while (0)
#define H_LOAD4(buf, TABu, k) do { const u32x4 i4_ = *(const LAS u32x4*)(listw + (k)); H_LOAD(buf[0], TABu, i4_[0]); H_LOAD(buf[1], TABu, i4_[1]); H_LOAD(buf[2], TABu, i4_[2]); H_LOAD(buf[3], TABu, i4_[3]); } while (0)
        {
            RowH ra[4], rb[4];
            H_LOAD4(ra, UTu, 0);
            int hh[8], hl[8]; float shs[2];
#pragma unroll
            for (int t = 0; t < 2; ++t) {
                float hv[32]; float m = 0.f;
#pragma unroll
                for (int k = 0; k < 8; ++k) { const u32x2 a = *(const u32x2*)(F.HB + (size_t)tok * D + t * 1024 + k * 128 + lq * 4);
                    hv[4 * k] = bf_lo(a[0]); hv[4 * k + 1] = bf_hi(a[0]); hv[4 * k + 2] = bf_lo(a[1]); hv[4 * k + 3] = bf_hi(a[1]); }
#pragma unroll
                for (int i = 0; i < 32; ++i) m = fmaxf(m, fabsf(hv[i]));
                const float sh = m > 0.f ? m * (1.0f / 119.0f) : 1.0f, ih = 1.0f / sh; shs[t] = sh;
#pragma unroll
                for (int dd = 0; dd < 4; ++dd) { unsigned ph = 0u, pl = 0u;
#pragma unroll
                    for (int n = 0; n < 8; ++n) { const int q = (int)rintf(hv[8 * dd + n] * ih); const int lo = ((q + 8) & 15) - 8, hi = (q - lo) >> 4;
                        ph |= (unsigned)(hi & 15) << (4 * n); pl |= (unsigned)(lo & 15) << (4 * n); }
                    hh[t * 4 + dd] = (int)ph; hl[t * 4 + dd] = (int)pl; }
            }
#pragma unroll 1
            for (int k0 = 0; k0 < 128; k0 += 8) {
                float pp[8];
                H_LOAD4(rb, UTu, k0 + 4);
#pragma unroll
                for (int q = 0; q < 4; ++q) { pp[q] = dot64i(ra[q], hh, hl, shs); }
                if (k0 != 120) H_LOAD4(ra, UTu, k0 + 8);
#pragma unroll
                for (int q = 0; q < 4; ++q) { pp[4 + q] = dot64i(rb[q], hh, hl, shs); }
                { const float t = reduce8h(pp, lq); if ((lq & 3) == 0) actl[k0 + (((lq >> 4) & 1) * 4 + ((lq >> 3) & 1) * 2 + ((lq >> 2) & 1))] = t; }
            }
        }
        RowH va[4], vb[4];
        H_LOAD4(va, VTu, 0);
#pragma unroll
        for (int r = 0; r < 4; ++r) { const int pos = r * 32 + lq; const float act = actl[pos]; listg[pos] = listg[pos] * 0.5f * act * (1.0f + erff(act * 0.70710678118654752f)); }
        h2v o[32];
#pragma unroll
        for (int j = 0; j < 32; ++j) o[j] = (h2v){(_Float16)0.f, (_Float16)0.f};
        {
#define H_AXPY4(buf, k) do { const f32x4 w4_ = *(const LAS f32x4*)(listg + (k)); _Pragma("unroll") for (int q = 0; q < 4; ++q) { axpy64(buf[q], o, w4_[q]); __builtin_amdgcn_sched_barrier(0); } } while (0)
#pragma unroll 1
            for (int k0 = 0; k0 < 128; k0 += 8) {
                H_LOAD4(vb, VTu, k0 + 4);
                H_AXPY4(va, k0);
                if (k0 != 120) H_LOAD4(va, VTu, k0 + 8);
                H_AXPY4(vb, k0 + 4);
            }
        }
#undef H_LOAD4
#undef H_AXPY4
#undef H_LOAD
        {
            int le = lq; asm volatile("; epilogue addresses rebuilt per token" : "+v"(le));
            const int grp = (tok < TP) ? 0 : 1 + ((tok - TP) >> 11);
            const float* md = F.MOD + (size_t)(l * 3 + grp) * 12288;
            bf16_t* xr = F.XB + (size_t)tok * D + le * 4;
            f32x4 xn[16]; float ss = 0.f;
#pragma unroll
            for (int t = 0; t < 2; ++t)
#pragma unroll
                for (int k = 0; k < 8; ++k) { bf16_t* xp = xr + t * 1024 + k * 128;
                    const u32x2 xw = *(const u32x2*)xp; const f32x4 xa = {bf_lo(xw.x), bf_hi(xw.x), bf_lo(xw.y), bf_hi(xw.y)}, ga = *(const f32x4*)(md + 10240 + le * 4 + t * 1024 + k * 128);
                    const f32x4 ov = {(float)o[t * 16 + 2 * k].x, (float)o[t * 16 + 2 * k].y, (float)o[t * 16 + 2 * k + 1].x, (float)o[t * 16 + 2 * k + 1].y};
                    const f32x4 v = xa + ga * ov; xn[t * 8 + k] = v; ss += v[0] * v[0] + v[1] * v[1] + v[2] * v[2] + v[3] * v[3];
                    if (l < 3) *(u32x2*)xp = (u32x2){pk_bf16(v[0], v[1]), pk_bf16(v[2], v[3])}; }
            ss = half_sum(ss);
            const float rstd = __frsqrt_rn(ss * (1.0f / 2048.0f) + EPS);
            if (l < 3) {
                const float* nw = F.norm_w + (size_t)(l + 1) * 2 * D; const float* mn = F.MOD + (size_t)((l + 1) * 3 + grp) * 12288;
#pragma unroll
                for (int t = 0; t < 2; ++t)
#pragma unroll
                    for (int k = 0; k < 8; ++k) { const int cidx = le * 4 + t * 1024 + k * 128;
                        const f32x4 nv = *(const f32x4*)(nw + cidx), sc = *(const f32x4*)(mn + 2048 + cidx), sh = *(const f32x4*)(mn + cidx);
                        const f32x4 hv = xn[t * 8 + k] * rstd * nv * (1.0f + sc) + sh;
                        *(u32x2*)(F.HB + (size_t)tok * D + cidx) = (u32x2){pk_bf16(hv[0], hv[1]), pk_bf16(hv[2], hv[3])}; }
            } else {
                float* yo = F.out + (size_t)tok * D + le * 4;
#pragma unroll
                for (int t = 0; t < 2; ++t)
#pragma unroll
                    for (int k = 0; k < 8; ++k) { const f32x4 na = *(const f32x4*)(F.final_norm_w + le * 4 + t * 1024 + k * 128); *(f32x4*)(yo + t * 1024 + k * 128) = xn[t * 8 + k] * rstd * na; }
            }
        }
    }
}

__global__ void __launch_bounds__(512, 2) mk_fwd(Args args) {
    extern __shared__ __attribute__((aligned(16))) unsigned char lds_raw[];
    Frame F;
    F.lds = (LAS unsigned char*)lds_raw; F.tid = threadIdx.x; F.lane = F.tid & 63; F.wave = __builtin_amdgcn_readfirstlane(F.tid >> 6);
    F.x_prompt = args.in[0]; F.x_sample = args.in[1]; F.state_in = args.in[2]; F.c = args.in[3]; F.c_ctx = args.in[4]; F.w_ada = args.in[5]; F.b_ada = args.in[6]; F.norm_w = args.in[7];
    F.w_in = args.in[8]; F.lower_bounds = args.in[9]; F.hgrn_norm_w = args.in[10]; F.w_pool = args.in[11]; F.pool_scale = args.in[12]; F.w_out = args.in[13]; F.w_query = args.in[14];
    F.sub_keys = args.in[15]; F.expert_u = args.in[16]; F.expert_v = args.in[17]; F.final_norm_w = args.in[18];
    unsigned char* ws = args.ws; F.out = args.out;
    F.MOD = (float*)(ws + WS_MOD); F.LB = (float*)(ws + WS_LB); F.WIN = (bf16_t*)(ws + WS_WIN); F.WOUT = (bf16_t*)(ws + WS_WOUT); F.WQ = (bf16_t*)(ws + WS_WQ); F.WINU = (bf16_t*)(ws + WS_WINU);
    F.WPOOL = (bf16_t*)(ws + WS_WPOOL); F.KEYS = (bf16_t*)(ws + WS_KEYS); F.UTAB = ws + WS_UTAB; F.VTAB = ws + WS_VTAB; F.USC = (float*)(ws + WS_USC); F.VSC = (float*)(ws + WS_VSC); F.X = (float*)(ws + WS_X); F.XB = (bf16_t*)(ws + WS_X); F.HB = (bf16_t*)(ws + WS_HB);
    F.P = (bf16_t*)(ws + WS_P); F.OF = (bf16_t*)(ws + WS_OF); F.OB = (bf16_t*)(ws + WS_OB); F.CAT = (bf16_t*)(ws + WS_CAT); F.Q = (bf16_t*)(ws + WS_Q); F.SELI = (int*)(ws + WS_SELI); F.SELG = (float*)(ws + WS_SELG); F.MODP = (float*)(ws + WS_MODP); F.QH = (bf16_t*)(ws + WS_QH); F.SSEG = (float*)(ws + WS_SSEG); F.DSEG = (float*)(ws + WS_DSEG);
    const int lo = args.ph_lo, hi = args.ph_hi;
    volatile LAS unsigned* misc = (volatile LAS unsigned*)(F.lds + MISC_OFF);
    if (F.tid < 4) misc[F.tid] = 0u;
    __syncthreads();
    XcdBarrier bar; bar.bar = (unsigned*)(ws + WS_CTL); bar.x = 0; bar.st = misc;
    if (hi - lo > 1) bar = xcd_barrier_post((unsigned*)(ws + WS_CTL), misc);
#define IN(k) (lo <= (k) && (k) < hi)
#define SEAM(k) do { if ((k) + 1 < hi) xcd_barrier(bar); } while (0)
    const int G = gridDim.x, bx = blockIdx.x;
    if (IN(0)) { for (int rep = 0; rep < NREP(0); ++rep) { if (KIND_ON(0)) p0_prologue(F); __syncthreads(); } SEAM(0); }
    if (IN(1)) {
        if (KIND_ON(1)) {
            pg8::Gemm g{F.WPOOL, F.WINU, 4096, 32768, 256, 256, 256}; pg8::PoolFoldOrder S{G, bx}; pg8::EpiPoolFold E{F.WIN};
            pg8::gemm_phase<pg8::EpiPoolFold, pg8::PoolFoldOrder>(F.lds, g, S, E, F.wave);
        }
        if (KIND_ON(6)) {
            for (int i = bx * 512 + fresh_tid(F.wave); i < 4 * 3 * 12288; i += G * 512) F.MOD[i] = ((F.MODP[i] + F.MODP[MODP_STRIDE + i]) + F.MODP[2 * MODP_STRIDE + i]) + F.MODP[3 * MODP_STRIDE + i];
            norm_rows<4, false>(F, F.x_prompt, F.x_sample, F.norm_w, F.MODP, 0, 2048);
        }
        SEAM(1);
    }
    for (int l = 0; l < 4; ++l) {
        const int pb = 2 + 9 * l;
        if (IN(pb) && KIND_ON(2)) for (int rep = 0; rep < NREP(2); ++rep) {
            pg8::Gemm g{F.HB, F.WIN + (size_t)l * 6144 * 2048, NTOK, DIN, D, D, D}; pg8::StaticOrder S; S.init(NTOK, DIN, G, bx); pg8::EpiBf16 E{F.P, DIN};
            pg8::gemm_phase<pg8::EpiBf16, pg8::StaticOrder>(F.lds, g, S, E, F.wave);
            if (rep == NREP(2) - 1) SEAM(pb);
        }
        if (IN(pb + 1)) { for (int rep = 0; rep < NREP(3); ++rep) { if (KIND_ON(3)) p3_scan(F, l); __syncthreads(); } SEAM(pb + 1); }
        if (IN(pb + 2)) { if (KIND_ON(3)) p3c_correct(F, l); SEAM(pb + 2); }
        if (IN(pb + 3)) { for (int rep = 0; rep < NREP(4); ++rep) if (KIND_ON(4)) p4_combine(F, l); SEAM(pb + 3); }
        if (IN(pb + 4) && KIND_ON(5)) {
            pg8::Gemm g{F.CAT, F.WOUT + (size_t)l * D * D, NTOK, D, D, D, D}; pg8::StaticOrder S; S.init(NTOK, D, G, bx);
            pg8::EpiRes E{l == 0 ? F.x_prompt : nullptr, l == 0 ? F.x_sample : nullptr, l == 0 ? nullptr : F.XB, F.XB, F.MOD + (size_t)l * 3 * 12288 + 4096};
            pg8::gemm_phase<pg8::EpiRes, pg8::StaticOrder>(F.lds, g, S, E, F.wave);
            SEAM(pb + 4);
        }
        if (IN(pb + 5)) { for (int rep = 0; rep < NREP(6); ++rep) if (KIND_ON(6)) norm_rows<1, true>(F, F.XB, F.XB + (size_t)TP * D, F.norm_w + (size_t)(l * 2 + 1) * D, F.MOD + (size_t)l * 3 * 12288, 6144, 8192); SEAM(pb + 5); }
        if (IN(pb + 6) && KIND_ON(7)) {
            pg8::Gemm g{F.HB, F.WQ + (size_t)l * D * D, NTOK, D, D, D, D}; pg8::StaticOrder S; S.init(NTOK, D, G, bx); pg8::EpiBf16 E{F.Q, D};
            const bool early = (bx >> 3) & 1, odd = F.wave & 1;
#pragma unroll 1
            for (int st = 0; st < 4; ++st) {
                if (st == 1) {
                    pg8::gemm_phase<pg8::EpiBf16, pg8::StaticOrder>(F.lds, g, S, E, F.wave);
                    asm volatile("s_waitcnt vmcnt(0)" ::: "memory");
                    __syncthreads();
                    if (F.tid == 0) { __builtin_amdgcn_fence(__ATOMIC_ACQUIRE, "agent"); asm volatile("s_waitcnt vmcnt(0)" ::: "memory"); }
                    __syncthreads();
                    continue;
                }
                const bool cv = early ? (st == 0) : ((st == 2 && !odd) || (st == 3 && odd));
                const bool tk = early ? (st == 2) : ((st == 2 && odd) || (st == 3 && !odd));
                if (cv && KIND_ON(8)) conv_tables(F, l);
                if (tk && KIND_ON(8)) p8_topk(F, l, S);
            }
            SEAM(pb + 6);
        }
        if (IN(pb + 8)) { if (KIND_ON(9)) p9_peer(F, l); SEAM(pb + 8); }
    }
}

extern "C" void kernel_launch(void* const* d_in, const int* in_sizes, int n_in, void* d_out, int out_size, void* d_ws, size_t ws_size, hipStream_t stream) {
    static int grid = 0;
    if (grid == 0) {
        if (n_in != 19 || ws_size < WS_END) { fprintf(stderr, "kernel_launch: expected 19 inputs and >= %zu bytes of workspace, got %d / %zu\n", (size_t)WS_END, n_in, ws_size); grid = -1; return; }
        int dev = 0, cus = 0, per_cu = 0;
        if (hipGetDevice(&dev) != hipSuccess || hipDeviceGetAttribute(&cus, hipDeviceAttributeMultiprocessorCount, dev) != hipSuccess) { grid = -1; return; }
        if (hipFuncSetAttribute((const void*)mk_fwd, hipFuncAttributeMaxDynamicSharedMemorySize, LDS_BYTES) != hipSuccess) { fprintf(stderr, "kernel_launch: hipFuncSetAttribute failed\n"); grid = -1; return; }
        if (hipOccupancyMaxActiveBlocksPerMultiprocessor(&per_cu, (const void*)mk_fwd, 512, LDS_BYTES) != hipSuccess || per_cu < 1) { fprintf(stderr, "kernel_launch: occupancy query says %d\n", per_cu); }
        (void)hipGetLastError();
        grid = cus;
    }
    if (grid < 0) return;
    (void)hipMemsetAsync((char*)d_ws + WS_CTL, 0, WS_MOD - WS_CTL, stream);
    Args a{};
    for (int i = 0; i < 19; ++i) a.in[i] = (const float*)d_in[i];
    a.out = (float*)d_out; a.ws = (unsigned char*)d_ws;
#if MK_ONE_LAUNCH
    a.ph_lo = 0; a.ph_hi = NPHASE;
    hipLaunchKernelGGL(mk_fwd, dim3(grid), dim3(512), LDS_BYTES, stream, a);
#else
    for (int ph = 0; ph < NPHASE; ++ph) { a.ph_lo = ph; a.ph_hi = ph + 1; hipLaunchKernelGGL(mk_fwd, dim3(grid), dim3(512), LDS_BYTES, stream, a); }
#endif
}
```

```cpp
#include <hip/hip_runtime.h>
#include <cstdio>
#include <cstdint>

#ifndef MK_ONE_LAUNCH
#define MK_ONE_LAUNCH 1
#endif
#ifndef MK_KIND_MASK
#define MK_KIND_MASK 0x3ff
#endif
#define KIND_ON(k) (((MK_KIND_MASK) >> (k)) & 1)
#ifndef MK_REPEAT_MASK
#define MK_REPEAT_MASK 0
#endif
#define NREP(k) (1 + (((MK_REPEAT_MASK) >> (k)) & 1))

#define DI __device__ __forceinline__
#define LAS __attribute__((address_space(3)))

typedef unsigned short bf16_t;
typedef short bf16x8 __attribute__((ext_vector_type(8)));
typedef float f32x2 __attribute__((ext_vector_type(2)));
typedef float f32x4 __attribute__((ext_vector_type(4)));
typedef float f32x16 __attribute__((ext_vector_type(16)));
typedef unsigned u32x2 __attribute__((ext_vector_type(2)));
typedef unsigned u32x4 __attribute__((ext_vector_type(4)));
typedef unsigned u32x6 __attribute__((ext_vector_type(6)));
typedef float f32x32 __attribute__((ext_vector_type(32)));
typedef _Float16 h2v __attribute__((ext_vector_type(2)));
typedef _Float16 h32v __attribute__((ext_vector_type(32)));
typedef __bf16 bf16x2_t __attribute__((ext_vector_type(2)));

constexpr int D = 2048, NTOK = 8192, TP = 4096, DIN = 6144, NMOD = 12288, NEXP = 16384;
constexpr float EPS = 1e-6f;
constexpr int NPHASE = 38;
constexpr int ROWB = 1152;

constexpr size_t WS_CTL = 0;
constexpr size_t WS_MOD = 65536;
constexpr size_t WS_LB = WS_MOD + (size_t)4 * 3 * 12288 * 4;
constexpr size_t WS_WIN = WS_LB + (size_t)2 * 4 * 1024 * 4;
constexpr size_t WS_WOUT = WS_WIN + (size_t)4 * 6144 * 2048 * 2;
constexpr size_t WS_WQ = WS_WOUT + (size_t)4 * 2048 * 2048 * 2;
constexpr size_t WS_WINU = WS_WQ + (size_t)4 * 2048 * 2048 * 2;
constexpr size_t WS_WPOOL = WS_WINU + (size_t)16 * 2048 * 256 * 2;
constexpr size_t WS_KEYS = WS_WPOOL + (size_t)16 * 256 * 256 * 2;
constexpr size_t WS_UTAB = WS_KEYS + (size_t)4 * 8 * 2 * 128 * 128 * 2;
constexpr size_t WS_VTAB = WS_UTAB + (size_t)4 * 16384 * 2048;
constexpr size_t WS_X = WS_VTAB + (size_t)4 * 16384 * 2048;
constexpr size_t WS_HB = WS_X + (size_t)8192 * 2048 * 4;
constexpr size_t WS_P = WS_HB + (size_t)8192 * 2048 * 2;
constexpr size_t WS_OF = WS_P + (size_t)8192 * 6144 * 2;
constexpr size_t WS_OB = WS_OF + (size_t)8192 * 1024 * 4;
constexpr size_t WS_CAT = WS_OB + (size_t)8192 * 1024 * 4;
constexpr size_t WS_Q = WS_CAT + (size_t)8192 * 2048 * 2;
constexpr size_t WS_SELI = WS_Q + (size_t)8192 * 2048 * 2;
constexpr size_t WS_SELG = WS_SELI + (size_t)8192 * 128 * 4;
constexpr size_t WS_MODP = WS_SELG + (size_t)8192 * 128 * 4;
constexpr size_t WS_USC = WS_MODP + (size_t)4 * 4 * 3 * 12288 * 4;
constexpr size_t WS_VSC = WS_USC + (size_t)4 * 16384 * 4;
constexpr size_t WS_QH = WS_VSC + (size_t)4 * 16384 * 4;
constexpr size_t WS_SSEG = WS_QH + (size_t)2 * 4096 * 1024 * 2;
constexpr size_t WS_DSEG = WS_SSEG + (size_t)256 * 16384 * 4;
constexpr size_t WS_END = WS_DSEG + (size_t)256 * 128 * 4;
constexpr size_t MODP_STRIDE = (size_t)4 * 3 * 12288;

constexpr int LDS_BYTES = 155648;
constexpr int MISC_OFF = LDS_BYTES - 256;

DI unsigned pk_bf16(float lo, float hi) { f32x2 v = {lo, hi}; bf16x2_t b = __builtin_convertvector(v, bf16x2_t); return __builtin_bit_cast(unsigned, b); }
DI float bf_lo(unsigned x) { return __uint_as_float(x << 16); }
DI float bf_hi(unsigned x) { return __uint_as_float(x & 0xffff0000u); }
template <int M> DI float xshfl(float v) {
    if constexpr (M < 32) return __int_as_float(__builtin_amdgcn_ds_swizzle(__float_as_int(v), (M << 10) | 0x1f));
    else { unsigned z = 0u; asm volatile("; rebuilt at each use, never kept" : "+v"(z)); const unsigned ad = (__builtin_amdgcn_mbcnt_hi(~0u, __builtin_amdgcn_mbcnt_lo(~0u, z)) ^ 32u) << 2; return __int_as_float(__builtin_amdgcn_ds_bpermute((int)ad, __float_as_int(v))); }
}
DI float wave_sum(float v) { v += xshfl<32>(v); v += xshfl<16>(v); v += xshfl<8>(v); v += xshfl<4>(v); v += xshfl<2>(v); v += xshfl<1>(v); return v; }
DI float fdot2(unsigned a, unsigned b, float c) { return __builtin_amdgcn_fdot2_f32_bf16(__builtin_bit_cast(bf16x2_t, a), __builtin_bit_cast(bf16x2_t, b), c, false); }
DI float silu_f(float x) { return x / (1.f + __expf(-x)); }
#define MFMA32(a, b, c) __builtin_amdgcn_mfma_f32_32x32x16_bf16((a), (b), (c), 0, 0, 0)
DI int fresh_tid(const int wave_s) { unsigned z = 0u; asm volatile("; fresh lane id" : "+v"(z)); const int t = (int)__builtin_amdgcn_mbcnt_hi(~0u, __builtin_amdgcn_mbcnt_lo(~0u, z)); return (wave_s << 6) | t; }
DI int crow(int i, int hh) { return (i & 3) + 8 * (i >> 2) + 4 * hh; }

#define XB_TMO      128
#define XB_XCNT(j)  (256  + 64 * (j))
#define XB_XSUB(j)  (1280 + 64 * (j))
#define XB_XGEN(j)  (2304 + 64 * (j))
#define XB_TOP      3328
#define XB_TOPGEN   3392
#define XCD_BAR_WORDS 3456
#define XB_SPIN_CAP (1u << 18)

__device__ __forceinline__ unsigned xb_ld(unsigned* p)              { return __hip_atomic_load(p, __ATOMIC_RELAXED, __HIP_MEMORY_SCOPE_AGENT); }
__device__ __forceinline__ unsigned xb_add(unsigned* p, unsigned v) { return __hip_atomic_fetch_add(p, v, __ATOMIC_RELAXED, __HIP_MEMORY_SCOPE_AGENT); }
__device__ __forceinline__ unsigned xb_xcc_id() { return (unsigned)__builtin_amdgcn_s_getreg((3 << 11) | 20) & 0xFu; }
#define XB_SPIN(cond, bar) do { unsigned _sp = 0; while (cond) { __builtin_amdgcn_s_sleep(1); \
    if ((++_sp & 255u) == 0u) { if (xb_ld(&(bar)[XB_TMO])) break; if (_sp > XB_SPIN_CAP) { atomicAdd(&(bar)[XB_TMO], 1u); break; } } } } while (0)

struct XcdBarrier {
    unsigned* bar; unsigned x;
    volatile LAS unsigned* st;
};
__device__ __forceinline__ XcdBarrier xcd_barrier_post(unsigned* bar, volatile LAS unsigned* st) {
    XcdBarrier b; b.bar = bar; b.x = xb_xcc_id(); b.st = st;
    if (threadIdx.x == 0) (void)xb_add(&bar[XB_XCNT(b.x)], 1u);
    return b;
}
__device__ __forceinline__ void xcd_barrier_complete(unsigned* bar, unsigned x, unsigned& nloc, unsigned& nx) {
    const unsigned G = gridDim.x * gridDim.y * gridDim.z;
    unsigned sum, cnt, mine, sp = 0u;
    for (;;) {
        sum = 0u; cnt = 0u; mine = 0u;
#pragma unroll
        for (unsigned j = 0; j < 16; ++j) { const unsigned c = xb_ld(&bar[XB_XCNT(j)]); sum += c; cnt += (c > 0u) ? 1u : 0u; mine = (j == x) ? c : mine; }
        if (sum == G) break;
        __builtin_amdgcn_s_sleep(1);
        if ((++sp & 255u) == 0u) { if (xb_ld(&bar[XB_TMO])) break; if (sp > XB_SPIN_CAP) { atomicAdd(&bar[XB_TMO], 1u); break; } }
    }
    nloc = mine > 0u ? mine : 1u; nx = cnt > 0u ? cnt : 1u;
}
__device__ __forceinline__ void xcd_barrier(const XcdBarrier& b) {
    asm volatile("s_waitcnt vmcnt(0)" ::: "memory");
    __syncthreads();
    if (threadIdx.x == 0) {
        unsigned* bar = b.bar;
        __builtin_amdgcn_s_waitcnt(0);
        unsigned nloc = b.st[0], nx = b.st[1];
        if (nloc == 0u) { xcd_barrier_complete(bar, b.x, nloc, nx); b.st[0] = nloc; b.st[1] = nx; }
        const unsigned old = xb_add(&bar[XB_XSUB(b.x)], 1u);
        const unsigned gen = old / nloc;
        if (old + 1u == (gen + 1u) * nloc) {
            __builtin_amdgcn_fence(__ATOMIC_RELEASE, "agent");
            asm volatile("s_waitcnt vmcnt(0)" ::: "memory");
            const unsigned og = xb_add(&bar[XB_TOP], 1u);
            const unsigned tg = og / nx;
            if (og + 1u == (tg + 1u) * nx) xb_add(&bar[XB_TOPGEN], 1u);
            else XB_SPIN(xb_ld(&bar[XB_TOPGEN]) == tg, bar);
            __builtin_amdgcn_fence(__ATOMIC_ACQUIRE, "agent");
            xb_add(&bar[XB_XGEN(b.x)], 1u);
            asm volatile("s_waitcnt vmcnt(0)" ::: "memory");
        } else {
            XB_SPIN(xb_ld(&bar[XB_XGEN(b.x)]) == gen, bar);
            __builtin_amdgcn_fence(__ATOMIC_ACQUIRE, "agent");
            asm volatile("s_waitcnt vmcnt(0)" ::: "memory");
        }
    }
    __syncthreads();
}

namespace pg8 {
constexpr int BM = 256, BK = 64, HALF = 128, HTB = HALF * BK * 2, STAGE_BYTES = 8 * HTB, NXCD = 8, WGM = 8;
__host__ __device__ __forceinline__ int lds_byte(int r, int c) { const int st = (r >> 4) * 2 + (c >> 5), rr = r & 15, cc = c & 31, ob = rr * 64 + cc * 2; return st * 1024 + (ob ^ (((ob >> 9) & 1) << 5)); }
__host__ __device__ __forceinline__ void stage_rc(int b, int& R, int& C) { const int st = b / 1024, sb = b % 1024, swz = sb ^ (((sb >> 9) & 1) << 5); R = (st >> 1) * 16 + swz / 64; C = (st & 1) * 32 + (swz % 64) / 2; }
__host__ __device__ __forceinline__ int perm32(int rho) { const int n = rho >> 4, i = rho & 15; return 8 * (i >> 2) + 4 * n + (i & 3); }

struct Unit { int pm, pn; };
struct Gemm { const bf16_t* A; const bf16_t* Bt; int M, N, K, lda, ldb; };

struct StaticOrder {
    int nM, nN, nwg, G, c;
    __host__ __device__ void init(int M, int N, int G_, int c_) { nM = M / BM; nN = N / BM; nwg = nM * nN; G = G_; c = c_; }
    __host__ __device__ bool next(int i, Unit& u) const {
        const long L = (long)i * G + c; if (L >= nwg) return false;
        int wgid = (int)L; { const int q = nwg / NXCD, r = nwg % NXCD, xcd = wgid % NXCD, off = wgid / NXCD; wgid = (xcd < r ? xcd * (q + 1) : r * (q + 1) + (xcd - r) * q) + off; }
        const int nig = WGM * nN, gid = wgid / nig, fm = gid * WGM, gsz = (nM - fm) < WGM ? (nM - fm) : WGM;
        u.pm = fm + ((wgid % nig) % gsz); u.pn = (wgid % nig) / gsz; return true;
    }
    __device__ __forceinline__ void a_ready(const Unit&) const {}
    __device__ __forceinline__ void done(const Unit&) const {}
};
struct PoolFoldOrder {
    int G, c;
    __device__ bool next(int i, Unit& u) const { const int L = i * G + c; if (L >= 128) return false; u.pm = L >> 3; u.pn = L; return true; }
    __device__ __forceinline__ void a_ready(const Unit&) const {}
    __device__ __forceinline__ void done(const Unit&) const {}
};

struct EpiBf16 {
    static constexpr bool PERM = true, AFTER_DRAIN = false;
    bf16_t* O; int ldc;
    __device__ __forceinline__ void operator()(const f32x4 (&acc)[2][2][4][2], const Unit& u, int wr, int wc, int fr, int fq) const {
        const int row0 = u.pm * BM + wr * 64 + fr; const int col0 = u.pn * BM + wc * 32 + 8 * fq;
#pragma unroll
        for (int ai = 0; ai < 2; ++ai)
#pragma unroll
            for (int m = 0; m < 4; ++m) { bf16_t* rowp = O + (size_t)(row0 + ai * HALF + m * 16) * ldc + col0;
#pragma unroll
                for (int bj = 0; bj < 2; ++bj) { const f32x4 v0 = acc[ai][bj][m][0], v1 = acc[ai][bj][m][1];
                    u32x4 w; w.x = pk_bf16(v0[0], v0[1]); w.y = pk_bf16(v0[2], v0[3]); w.z = pk_bf16(v1[0], v1[1]); w.w = pk_bf16(v1[2], v1[3]);
                    *(u32x4*)(rowp + bj * HALF) = w; } }
    }
};
struct EpiPoolFold {
    static constexpr bool PERM = true, AFTER_DRAIN = false;
    bf16_t* WIN;
    __device__ __forceinline__ void operator()(const f32x4 (&acc)[2][2][4][2], const Unit& u, int wr, int wc, int fr, int fq) const {
        const int lg = u.pm, l = lg >> 2, g = lg & 3, kt = u.pn & 7;
        bf16_t* base = WIN + ((size_t)l * 6144 + 5120 + g * 256) * 2048 + kt * 256;
        const int row0 = wr * 64 + fr, col0 = wc * 32 + 8 * fq;
#pragma unroll
        for (int ai = 0; ai < 2; ++ai)
#pragma unroll
            for (int m = 0; m < 4; ++m) { bf16_t* rowp = base + (size_t)(row0 + ai * HALF + m * 16) * 2048 + col0;
#pragma unroll
                for (int bj = 0; bj < 2; ++bj) { const f32x4 v0 = acc[ai][bj][m][0], v1 = acc[ai][bj][m][1];
                    u32x4 w; w.x = pk_bf16(v0[0], v0[1]); w.y = pk_bf16(v0[2], v0[3]); w.z = pk_bf16(v1[0], v1[1]); w.w = pk_bf16(v1[2], v1[3]);
                    *(u32x4*)(rowp + bj * HALF) = w; } }
    }
};
struct EpiRes {
    static constexpr bool PERM = true, AFTER_DRAIN = false;
    const float* xin_p; const float* xin_s; const bf16_t* xin_b; bf16_t* xout; const float* gate;
    __device__ __forceinline__ void operator()(const f32x4 (&acc)[2][2][4][2], const Unit& u, int wr, int wc, int fr, int fq) const {
        const int row0 = u.pm * BM + wr * 64 + fr, col0 = u.pn * BM + wc * 32 + 8 * fq;
        const int grp = (u.pm < 16) ? 0 : 1 + ((u.pm - 16) >> 3);
        const float* gp = gate + (size_t)grp * 12288 + col0;
        f32x4 gv[2][2];
#pragma unroll
        for (int bj = 0; bj < 2; ++bj)
#pragma unroll
            for (int n = 0; n < 2; ++n) gv[bj][n] = *(const f32x4*)(gp + bj * HALF + n * 4);
#pragma unroll
        for (int ai = 0; ai < 2; ++ai)
#pragma unroll
            for (int m = 0; m < 4; ++m) { const int row = row0 + ai * HALF + m * 16;
#pragma unroll
                for (int bj = 0; bj < 2; ++bj) { f32x4 x0, x1;
                    if (xin_b) { const u32x4 w = *(const u32x4*)(xin_b + (size_t)row * D + col0 + bj * HALF); x0 = (f32x4){bf_lo(w.x), bf_hi(w.x), bf_lo(w.y), bf_hi(w.y)}; x1 = (f32x4){bf_lo(w.z), bf_hi(w.z), bf_lo(w.w), bf_hi(w.w)}; }
                    else { const float* xi = (row < TP ? xin_p + (size_t)row * D : xin_s + (size_t)(row - TP) * D) + col0 + bj * HALF; x0 = *(const f32x4*)xi; x1 = *(const f32x4*)(xi + 4); }
                    const f32x4 r0 = x0 + gv[bj][0] * acc[ai][bj][m][0], r1 = x1 + gv[bj][1] * acc[ai][bj][m][1];
                    u32x4 o; o.x = pk_bf16(r0[0], r0[1]); o.y = pk_bf16(r0[2], r0[3]); o.z = pk_bf16(r1[0], r1[1]); o.w = pk_bf16(r1[2], r1[3]);
                    *(u32x4*)(xout + (size_t)row * D + col0 + bj * HALF) = o; } }
    }
};

template <class Epi, class Sched>
__device__ __forceinline__ void gemm_phase(LAS unsigned char* lds, const Gemm g, const Sched& S, const Epi& E, const int wave_s) {
    const int tid = fresh_tid(wave_s), wid = __builtin_amdgcn_readfirstlane(tid >> 6), lane = tid & 63, wr = wid >> 2, wc = wid & 3, fr = lane & 15, fq = lane >> 4;
    const int K = g.K, nt = K / BK;
    unsigned voffA[2], voffB[2];
#pragma unroll
    for (int i = 0; i < 2; ++i) { int R, C; stage_rc(tid * 16 + i * 8192, R, C); const int Rb = Epi::PERM ? ((R & ~31) + perm32(R & 31)) : R;
        voffA[i] = (unsigned)(R * g.lda + C) * 2u; voffB[i] = (unsigned)(Rb * g.ldb + C) * 2u; }
    const size_t kstep = (size_t)(BK * 2);
    const size_t hstepA = (size_t)HALF * g.lda * 2, hstepB = (size_t)HALF * g.ldb * 2;
    const size_t tstepA = 2 * hstepA, tstepB = 2 * hstepB;
    const unsigned ldsw = (unsigned)wid * 1024u;
    const int aoff = lds_byte(wr * 64 + fr, fq * 8), boff = lds_byte(wc * 32 + fr, fq * 8);
#define PG8_SA(b, h) (((b) * 2 + (h)) * HTB)
#define PG8_SB(b, h) ((4 + (b) * 2 + (h)) * HTB)
#define PG8_STAGE(bufoff, gbase, voff) do { _Pragma("unroll") for (int _i = 0; _i < 2; ++_i) \
        __builtin_amdgcn_global_load_lds((const unsigned*)((const char*)(gbase) + (voff)[_i]), (LAS unsigned*)(lds + (bufoff) + ldsw + _i * 8192), 16, 0, 0); } while (0)
#define PG8_LDA(dst, b, h) do { _Pragma("unroll") for (int m = 0; m < 4; ++m) _Pragma("unroll") for (int k = 0; k < 2; ++k) dst[m][k] = *(const LAS bf16x8*)(lds + PG8_SA(b, h) + aoff + m * 2048 + k * 1024); } while (0)
#define PG8_LDB(dst, b, h) do { _Pragma("unroll") for (int n = 0; n < 2; ++n) _Pragma("unroll") for (int k = 0; k < 2; ++k) dst[n][k] = *(const LAS bf16x8*)(lds + PG8_SB(b, h) + boff + n * 2048 + k * 1024); } while (0)
#define PG8_MMA(ai, bj, At, Bt) do { __builtin_amdgcn_s_setprio(1); _Pragma("unroll") for (int m = 0; m < 4; ++m) _Pragma("unroll") for (int n = 0; n < 2; ++n) _Pragma("unroll") for (int k = 0; k < 2; ++k) \
        acc[ai][bj][m][n] = __builtin_amdgcn_mfma_f32_16x16x32_bf16(Bt[n][k], At[m][k], acc[ai][bj][m][n], 0, 0, 0); __builtin_amdgcn_s_setprio(0); } while (0)
#define PG8_WAIT_V(n) asm volatile("s_waitcnt vmcnt(" #n ")" ::: "memory")
#define PG8_WAIT_L(n) asm volatile("s_waitcnt lgkmcnt(" #n ")" ::: "memory")
#define PG8_BAR __builtin_amdgcn_s_barrier()
#define PG8_SCHED __builtin_amdgcn_sched_barrier(0)
    Unit cur, nxt; int ui = 0;
    if (!S.next(0, cur)) return;
    f32x4 acc[2][2][4][2];
#pragma unroll
    for (int a = 0; a < 2; ++a)
#pragma unroll
        for (int b = 0; b < 2; ++b)
#pragma unroll
            for (int m = 0; m < 4; ++m)
#pragma unroll
                for (int n = 0; n < 2; ++n) acc[a][b][m][n] = (f32x4){0.f, 0.f, 0.f, 0.f};
    bf16x8 At[4][2], B0[2][2], B1[2][2];
    const char* cA = (const char*)g.A + (size_t)cur.pm * tstepA; const char* cB = (const char*)g.Bt + (size_t)cur.pn * tstepB;
    S.a_ready(cur);
    PG8_STAGE(PG8_SB(0, 0), cB, voffB); PG8_STAGE(PG8_SA(0, 0), cA, voffA); PG8_STAGE(PG8_SB(0, 1), cB + hstepB, voffB); PG8_STAGE(PG8_SA(0, 1), cA + hstepA, voffA);
    if (wr == 1) PG8_BAR;
    PG8_WAIT_V(4); PG8_BAR;
    PG8_STAGE(PG8_SB(1, 0), cB + kstep, voffB); PG8_STAGE(PG8_SA(1, 0), cA + kstep, voffA); PG8_STAGE(PG8_SB(1, 1), cB + hstepB + kstep, voffB);
    PG8_WAIT_V(6); PG8_BAR;
    for (;;) {
        const bool has_next = S.next(ui + 1, nxt);
        const char* nA = has_next ? (const char*)g.A + (size_t)nxt.pm * tstepA : cA; const char* nB = has_next ? (const char*)g.Bt + (size_t)nxt.pn * tstepB : cB;
        for (int t = 0; t < nt; t += 2) {
            const bool last = (t == nt - 2);
            const char* a1 = cA + (size_t)(t + 1) * kstep;
            const char* a2 = last ? nA : cA + (size_t)(t + 2) * kstep; const char* b2 = last ? nB : cB + (size_t)(t + 2) * kstep;
            const char* a3 = a2 + kstep; const char* b3 = b2 + kstep;
            if (last && has_next) S.a_ready(nxt);
            PG8_LDB(B0, 0, 0); PG8_SCHED; PG8_LDA(At, 0, 0); PG8_STAGE(PG8_SA(1, 1), a1 + hstepA, voffA);
            PG8_WAIT_L(8); PG8_BAR; PG8_WAIT_L(0); PG8_MMA(0, 0, At, B0); PG8_BAR; PG8_SCHED;
            PG8_LDB(B1, 0, 1); PG8_STAGE(PG8_SB(0, 0), b2, voffB);
            PG8_BAR; PG8_WAIT_L(0); PG8_MMA(0, 1, At, B1); PG8_BAR;
            PG8_LDA(At, 0, 1); PG8_STAGE(PG8_SA(0, 0), a2, voffA);
            PG8_BAR; PG8_WAIT_L(0); PG8_MMA(1, 0, At, B0); PG8_BAR; PG8_SCHED;
            PG8_STAGE(PG8_SB(0, 1), b2 + hstepB, voffB);
            PG8_WAIT_V(6); PG8_BAR; PG8_MMA(1, 1, At, B1); PG8_BAR;
            PG8_LDB(B0, 1, 0); PG8_SCHED; PG8_LDA(At, 1, 0); PG8_STAGE(PG8_SA(0, 1), a2 + hstepA, voffA);
            PG8_WAIT_L(8); PG8_BAR; PG8_WAIT_L(0); PG8_MMA(0, 0, At, B0); PG8_BAR; PG8_SCHED;
            PG8_LDB(B1, 1, 1); PG8_STAGE(PG8_SB(1, 0), b3, voffB);
            PG8_BAR; PG8_WAIT_L(0); PG8_MMA(0, 1, At, B1); PG8_BAR;
            PG8_LDA(At, 1, 1); PG8_STAGE(PG8_SA(1, 0), a3, voffA);
            PG8_BAR; PG8_WAIT_L(0); PG8_MMA(1, 0, At, B0); PG8_BAR; PG8_SCHED;
            PG8_STAGE(PG8_SB(1, 1), b3 + hstepB, voffB);
            PG8_WAIT_V(6); PG8_BAR; PG8_MMA(1, 1, At, B1); PG8_BAR;
        }
        E(acc, cur, wr, wc, fr, fq); S.done(cur);
        if (!has_next) break;
#pragma unroll
        for (int a = 0; a < 2; ++a)
#pragma unroll
            for (int b = 0; b < 2; ++b)
#pragma unroll
                for (int m = 0; m < 4; ++m)
#pragma unroll
                    for (int n = 0; n < 2; ++n) acc[a][b][m][n] = (f32x4){0.f, 0.f, 0.f, 0.f};
        cur = nxt; cA = nA; cB = nB; ++ui;
    }
    PG8_WAIT_V(0);
    if (wr == 0) PG8_BAR;
    PG8_BAR;
#undef PG8_SA
#undef PG8_SB
#undef PG8_STAGE
#undef PG8_LDA
#undef PG8_LDB
#undef PG8_MMA
#undef PG8_WAIT_V
#undef PG8_WAIT_L
#undef PG8_BAR
#undef PG8_SCHED
}
}

struct Args { const float* in[19]; float* out; unsigned char* ws; int ph_lo, ph_hi; };
struct Frame {
    LAS unsigned char* lds; int tid, lane, wave;
    const float *x_prompt, *x_sample, *state_in, *c, *c_ctx, *w_ada, *b_ada, *norm_w, *w_in, *lower_bounds, *hgrn_norm_w, *w_pool, *pool_scale, *w_out, *w_query, *sub_keys, *expert_u, *expert_v, *final_norm_w;
    float* out; float* MOD; float* LB; bf16_t *WIN, *WOUT, *WQ, *WINU, *WPOOL, *KEYS; unsigned char *UTAB, *VTAB; float *USC, *VSC; float* X; bf16_t* XB; bf16_t *HB, *P; bf16_t *OF, *OB; bf16_t *CAT, *Q; int* SELI; float* SELG; float* MODP; bf16_t* QH; float *SSEG, *DSEG;
};

DI void p0_prologue(const Frame& F) {
    LAS float* sv = (LAS float*)(F.lds);
    LAS float* red = (LAS float*)(F.lds + 24576);
    LAS float* tile = (LAS float*)(F.lds + 49152);
    const int tid = fresh_tid(F.wave), lane = tid & 63, wave = __builtin_amdgcn_readfirstlane(tid >> 6), b = blockIdx.x, G = gridDim.x;
    for (int i = tid; i < 3 * 2048; i += 512) { const int g = i >> 11, k = i & 2047; const float cv = (g == 0) ? F.c_ctx[k] : F.c[(g - 1) * 2048 + k]; sv[i] = silu_f(cv); }
    __syncthreads();
    for (int task = b; task < 768; task += G) {
        const int l = task / 192, rem = task % 192, cb = rem >> 2, kq = rem & 3;
        const float* W = F.w_ada + (size_t)l * 2048 * 12288 + cb * 256 + lane * 4;
        const int r0 = kq * 512 + wave * 64;
        f32x4 a0 = {0.f, 0.f, 0.f, 0.f}, a1 = a0, a2 = a0;
#pragma unroll 8
        for (int r = r0; r < r0 + 64; ++r) {
            const f32x4 w = __builtin_nontemporal_load((const f32x4*)(W + (size_t)r * 12288));
            a0 += sv[r] * w; a1 += sv[2048 + r] * w; a2 += sv[4096 + r] * w;
        }
        LAS float* rp = red + (wave * 3) * 256 + lane * 4;
        *(LAS f32x4*)(rp) = a0; *(LAS f32x4*)(rp + 256) = a1; *(LAS f32x4*)(rp + 512) = a2;
        __syncthreads();
        for (int i = tid; i < 768; i += 512) { const int g = i >> 8, cc = i & 255; float s = 0.f;
#pragma unroll
            for (int w = 0; w < 8; ++w) s += red[(w * 3 + g) * 256 + cc];
            const int n = cb * 256 + cc; if (kq == 0) s += F.b_ada[l * 12288 + n];
            F.MODP[(size_t)kq * MODP_STRIDE + ((size_t)(l * 3 + g)) * 12288 + n] = s; }
        __syncthreads();
    }
    if (b == G - 1) {
        for (int i = tid; i < 2048; i += 512) { const int d = i >> 10, j = i & 1023; float v[4], m = -1e30f;
#pragma unroll
            for (int l = 0; l < 4; ++l) { v[l] = F.lower_bounds[(d * 4 + l) * 1024 + j]; m = fmaxf(m, v[l]); }
            float s = 0.f;
#pragma unroll
            for (int l = 0; l < 4; ++l) { v[l] = __expf(v[l] - m); s += v[l]; }
            const float inv = 1.f / s; float cum = 0.f; const float p0 = v[0] * inv;
#pragma unroll
            for (int l = 0; l < 4; ++l) { cum += v[l] * inv; F.LB[(d * 4 + l) * 1024 + j] = cum - p0; } }
    }
    constexpr int T_WIN = 4 * 3072, T_WOUT = 4 * 1024, T_WQ = 4 * 1024, T_WPOOL = 256, T_ALL = T_WIN + T_WOUT + T_WQ + T_WPOOL;
    for (int t = b; t < T_ALL; t += G) {
        const float* src; bf16_t* dst; int lsrc, ldst; bool plain = false;
        if (t < T_WIN) { const int l = t / 3072, r = t % 3072, kt = r / 96, nt = r % 96;
            src = F.w_in + (size_t)l * 2048 * 6144 + (size_t)(kt * 64) * 6144 + nt * 64; lsrc = 6144;
            if (nt < 80) { dst = F.WIN + (size_t)l * 6144 * 2048 + (size_t)(nt * 64) * 2048 + kt * 64; ldst = 2048; }
            else { const int n = nt * 64 - 5120, g = n >> 8, cc = n & 255; dst = F.WINU + ((size_t)(l * 4 + g) * 2048 + kt * 64) * 256 + cc; ldst = 256; plain = true; } }
        else if (t < T_WIN + T_WOUT + T_WQ) { const bool isq = t >= T_WIN + T_WOUT; const int tt = t - T_WIN - (isq ? T_WOUT : 0), l = tt >> 10, kt = (tt & 1023) >> 5, nt = tt & 31;
            src = (isq ? F.w_query : F.w_out) + (size_t)l * 2048 * 2048 + (size_t)(kt * 64) * 2048 + nt * 64; lsrc = 2048;
            dst = (isq ? F.WQ : F.WOUT) + (size_t)l * 2048 * 2048 + (size_t)(nt * 64) * 2048 + kt * 64; ldst = 2048; }
        else { const int tt = t - T_WIN - T_WOUT - T_WQ, mtx = tt >> 4, ct = (tt & 15) >> 2, dt = tt & 3;
            src = F.w_pool + (size_t)mtx * 65536 + (size_t)(ct * 64) * 256 + dt * 64; lsrc = 256;
            dst = F.WPOOL + (size_t)mtx * 65536 + (size_t)(dt * 64) * 256 + ct * 64; ldst = 256; }
        const int r = tid >> 4, c4 = (tid & 15) * 4;
        const f32x4 v0 = *(const f32x4*)(src + (size_t)r * lsrc + c4), v1 = *(const f32x4*)(src + (size_t)(r + 32) * lsrc + c4);
        if (plain) {
            u32x2 o0 = {pk_bf16(v0[0], v0[1]), pk_bf16(v0[2], v0[3])}, o1 = {pk_bf16(v1[0], v1[1]), pk_bf16(v1[2], v1[3])};
            *(u32x2*)(dst + (size_t)r * ldst + c4) = o0; *(u32x2*)(dst + (size_t)(r + 32) * ldst + c4) = o1;
        } else {
#pragma unroll
            for (int j = 0; j < 4; ++j) { tile[r * 65 + c4 + j] = v0[j]; tile[(r + 32) * 65 + c4 + j] = v1[j]; }
            __syncthreads();
            const int n = tid >> 3, kk = (tid & 7) * 8; float f[8];
#pragma unroll
            for (int j = 0; j < 8; ++j) f[j] = tile[(kk + j) * 65 + n];
            u32x4 o = {pk_bf16(f[0], f[1]), pk_bf16(f[2], f[3]), pk_bf16(f[4], f[5]), pk_bf16(f[6], f[7])};
            *(u32x4*)(dst + (size_t)n * ldst + kk) = o;
            __syncthreads();
        }
    }
    const size_t k8 = (size_t)4 * 8 * 2 * 128 * 128 / 8;
    for (size_t i = (size_t)b * 512 + tid; i < k8; i += (size_t)G * 512) {
        const f32x4* s = (const f32x4*)F.sub_keys + 2 * i; const f32x4 a = s[0], cc = s[1];
        u32x4 o = {pk_bf16(a[0], a[1]), pk_bf16(a[2], a[3]), pk_bf16(cc[0], cc[1]), pk_bf16(cc[2], cc[3])}; ((u32x4*)F.KEYS)[i] = o; }
}

DI void conv_tables(const Frame& F, const int l) {
    const int tid = fresh_tid(F.wave), lane = tid & 63, wave = __builtin_amdgcn_readfirstlane(tid >> 6), b = blockIdx.x, G = gridDim.x;
    int r_beg = l * 16384 + b * 8 + wave, r_end = (l + 1) * 16384, r_step = G * 8;
    if ((G & 15) == 0) { const int half = G >> 1, gidx = ((b >> 4) << 3) | (b & 7); const bool early = (b >> 3) & 1; constexpr int R_E = 9728;
        r_beg = l * 16384 + (early ? 0 : R_E) + gidx * 8 + wave; r_end = l * 16384 + (early ? R_E : 16384); r_step = half * 8; }
    for (int row = r_beg; row < r_end; row += r_step) {
#pragma unroll
        for (int tb = 0; tb < 2; ++tb) {
            const float* src = (tb ? F.expert_v : F.expert_u) + (size_t)row * D + (lane >> 5) * 1024 + (lane & 31) * 4;
            f32x4 v[8]; float m = 0.f;
#pragma unroll
            for (int k = 0; k < 8; ++k) v[k] = __builtin_nontemporal_load((const f32x4*)(src + k * 128));
#pragma unroll
            for (int k = 0; k < 8; ++k) m = fmaxf(fmaxf(m, fmaxf(fabsf(v[k][0]), fabsf(v[k][1]))), fmaxf(fabsf(v[k][2]), fabsf(v[k][3])));
            float sc = m > 0.f ? m * (tb == 0 ? (1.0f / 7.0f) : (1.0f / 6.0f)) : 1.0f;
            const unsigned scb = (__float_as_uint(sc) + 0xffffu) >> 16; sc = __uint_as_float(scb << 16);
            const float inv = 1.0f / sc;
            unsigned pw[4];
            if (tb == 0) {
#pragma unroll
                for (int dd = 0; dd < 4; ++dd) { unsigned p = 0u;
#pragma unroll
                    for (int n = 0; n < 8; ++n) { const float xq = ((n < 4) ? v[2 * dd][n & 3] : v[2 * dd + 1][n & 3]) * inv; int q = (int)rintf(xq); q = q < -8 ? -8 : (q > 7 ? 7 : q); p |= (unsigned)(q & 15) << (4 * n); }
                    pw[dd] = p; }
            } else {
#pragma unroll
            for (int dd = 0; dd < 4; ++dd) { unsigned p = 0u;
                p = __builtin_amdgcn_cvt_scalef32_pk_fp4_f32(p, v[2 * dd][0] * inv, v[2 * dd][1] * inv, 1.0f, 0);
                p = __builtin_amdgcn_cvt_scalef32_pk_fp4_f32(p, v[2 * dd][2] * inv, v[2 * dd][3] * inv, 1.0f, 1);
                p = __builtin_amdgcn_cvt_scalef32_pk_fp4_f32(p, v[2 * dd + 1][0] * inv, v[2 * dd + 1][1] * inv, 1.0f, 2);
                p = __builtin_amdgcn_cvt_scalef32_pk_fp4_f32(p, v[2 * dd + 1][2] * inv, v[2 * dd + 1][3] * inv, 1.0f, 3);
                pw[dd] = p; }
            }
            unsigned char* dst = (tb ? F.VTAB : F.UTAB) + (size_t)row * ROWB;
            *(u32x4*)(dst + (lane & 31) * 32 + (lane >> 5) * 16) = (u32x4){pw[0], pw[1], pw[2], pw[3]};
            *(unsigned short*)(dst + 1024 + (lane & 31) * 4 + (lane >> 5) * 2) = (unsigned short)scb;
        }
    }
}

template <int NPART, bool XB> DI void norm_rows(const Frame& F, const void* xpv, const void* xsv, const float* nw, const float* modl, int sh_off, int sc_off) {
    const int tid = fresh_tid(F.wave), lane = tid & 63, wave = __builtin_amdgcn_readfirstlane(tid >> 6);
    for (int row = blockIdx.x * 8 + wave; row < NTOK; row += gridDim.x * 8) {
        const float* x = (row < TP) ? (const float*)xpv + (size_t)row * D : (const float*)xsv + (size_t)(row - TP) * D;
        const bf16_t* xb = (row < TP) ? (const bf16_t*)xpv + (size_t)row * D : (const bf16_t*)xsv + (size_t)(row - TP) * D;
        const int grp = (row < TP) ? 0 : 1 + ((row - TP) >> 11);
        const float* md = modl + (size_t)grp * 12288;
        f32x4 v[8]; float ss = 0.f;
#pragma unroll
        for (int j = 0; j < 8; ++j) { if (XB) { const u32x2 w = *(const u32x2*)(xb + j * 256 + lane * 4); v[j] = (f32x4){bf_lo(w.x), bf_hi(w.x), bf_lo(w.y), bf_hi(w.y)}; } else v[j] = *(const f32x4*)(x + j * 256 + lane * 4); ss += v[j][0] * v[j][0] + v[j][1] * v[j][1] + v[j][2] * v[j][2] + v[j][3] * v[j][3]; }
        ss = wave_sum(ss);
        const float rstd = __frsqrt_rn(ss * (1.0f / 2048.0f) + EPS);
#pragma unroll
        for (int j = 0; j < 8; ++j) { const int cidx = j * 256 + lane * 4;
            const f32x4 w = *(const f32x4*)(nw + cidx); f32x4 sc = *(const f32x4*)(md + sc_off + cidx), sh = *(const f32x4*)(md + sh_off + cidx);
#pragma unroll
            for (int p = 1; p < NPART; ++p) { sc += *(const f32x4*)(md + p * MODP_STRIDE + sc_off + cidx); sh += *(const f32x4*)(md + p * MODP_STRIDE + sh_off + cidx); }
            const f32x4 h = v[j] * rstd * w * (1.0f + sc) + sh;
            u32x2 o = {pk_bf16(h[0], h[1]), pk_bf16(h[2], h[3])};
            *(u32x2*)(F.HB + (size_t)row * D + cidx) = o; }
    }
}

constexpr int SC_QT = 0, SC_KH = 8704, SC_KT = 17408, SC_VT = 27648, SC_EB = 37888, SC_BUF = 38400;
DI bf16x8 pack8(const f32x16& x, const int s) {
    u32x4 p = {pk_bf16(x[8 * s], x[8 * s + 1]), pk_bf16(x[8 * s + 2], x[8 * s + 3]), pk_bf16(x[8 * s + 4], x[8 * s + 5]), pk_bf16(x[8 * s + 6], x[8 * s + 7])};
    return __builtin_bit_cast(bf16x8, p);
}
DI bf16x8 lds_2x8(const LAS unsigned char* p) {
    const u32x2 a = *(const LAS u32x2*)p, b = *(const LAS u32x2*)(p + 16);
    u32x4 r = {a[0], a[1], b[0], b[1]}; return __builtin_bit_cast(bf16x8, r);
}
DI void p3_scan(const Frame& F, const int l) {
    const int b = blockIdx.x; if (b >= 256) return;
    int tok0, T, bseq, h, cbeg; bool sample;
    if (b < 128) { sample = false; bseq = b >> 3; h = b & 7; T = 256; tok0 = bseq * 256; cbeg = 0; }
    else { sample = true; const int ix = b - 128; bseq = ix >> 6; cbeg = ((ix >> 3) & 7) * 8; h = ix & 7; T = 2048; tok0 = TP + bseq * 2048; }
    const int tid = fresh_tid(F.wave), lane = tid & 63, wave = __builtin_amdgcn_readfirstlane(tid >> 6);
    const int dir = wave >> 2, wv = wave & 3, r = lane & 31, hh = lane >> 5;
    LAS unsigned char* gbase = F.lds + dir * (2 * SC_BUF);
    const int cp = lane & 15, tg = lane >> 4, ch0 = 32 * wv + 2 * cp;
    const float lb0 = F.LB[(dir * 4 + l) * 1024 + h * 128 + ch0], lb1 = F.LB[(dir * 4 + l) * 1024 + h * 128 + ch0 + 1];
    const float om0 = 1.f - lb0, om1 = 1.f - lb1;
    const bf16_t* pcol = F.P + h * 128 + ch0;
    const int zoff = 1024 * (1 + dir);
    bf16_t* obuf = (dir ? F.OB : F.OF) + h * 128 + 32 * wv + r;
    f32x16 S[4];
#pragma unroll
    for (int mb = 0; mb < 4; ++mb)
#pragma unroll
        for (int i = 0; i < 16; ++i) S[mb][i] = 0.f;
    float bprev0 = 0.f, bprev1 = 0.f;
    unsigned qq[8], zz[8], vv[8], qn[8], zn[8], vn[8];
#pragma unroll
    for (int j = 0; j < 8; ++j) { int pos = cbeg * 32 + 8 * tg + j; if (dir) pos = T - 1 - pos; const bf16_t* rowp = pcol + (size_t)(tok0 + pos) * DIN;
        qq[j] = *(const unsigned*)rowp; zz[j] = *(const unsigned*)(rowp + zoff); vv[j] = *(const unsigned*)(rowp + 3072); }
#pragma unroll
    for (int j = 0; j < 8; ++j) { int pos = (cbeg + 1) * 32 + 8 * tg + j; if (dir) pos = T - 1 - pos; const bf16_t* rowp = pcol + (size_t)(tok0 + pos) * DIN;
        qn[j] = *(const unsigned*)rowp; zn[j] = *(const unsigned*)(rowp + zoff); vn[j] = *(const unsigned*)(rowp + 3072); }
    const float scale = 0.08838834764831845f;
    for (int c = cbeg; c < cbeg + 8; ++c) {
        LAS unsigned char* buf = gbase + (c & 1) * SC_BUF;
        {
            float bc0[8], bc1[8], k0[8], k1[8]; float run0 = 0.f, run1 = 0.f;
#pragma unroll
            for (int j = 0; j < 8; ++j) {
                const float z0 = fmaxf(bf_lo(zz[j]), -80.f), z1 = fmaxf(bf_hi(zz[j]), -80.f);
                const float e0 = __expf(-z0), e1 = __expf(-z1);
                const float s0 = __builtin_amdgcn_rcpf(1.f + e0), s1 = __builtin_amdgcn_rcpf(1.f + e1);
                const float f0 = lb0 + om0 * s0, f1 = lb1 + om1 * s1;
                k0[j] = om0 * e0 * s0; k1[j] = om1 * e1 * s1;
                run0 += __logf(f0); run1 += __logf(f1); bc0[j] = run0; bc1[j] = run1;
            }
#define LANE_GET(v, ln) __int_as_float(__builtin_amdgcn_ds_bpermute((ln) << 2, __float_as_int(v)))
            const float a00 = LANE_GET(run0, cp), a01 = LANE_GET(run0, cp + 16), a02 = LANE_GET(run0, cp + 32), a03 = LANE_GET(run0, cp + 48);
            const float a10 = LANE_GET(run1, cp), a11 = LANE_GET(run1, cp + 16), a12 = LANE_GET(run1, cp + 32), a13 = LANE_GET(run1, cp + 48);
#undef LANE_GET
            const float off0 = (tg > 0 ? a00 : 0.f) + (tg > 1 ? a01 : 0.f) + (tg > 2 ? a02 : 0.f);
            const float off1 = (tg > 0 ? a10 : 0.f) + (tg > 1 ? a11 : 0.f) + (tg > 2 ? a12 : 0.f);
            unsigned kt0[4], kt1[4], vt0[4], vt1[4]; float kh0[8], kh1[8];
            const float ep0 = __expf(bprev0), ep1 = __expf(bprev1);
#pragma unroll
            for (int j = 0; j < 8; ++j) {
                const float B0 = off0 + bc0[j], B1 = off1 + bc1[j];
                const float eq0 = __expf(B0), eq1 = __expf(B1), ek0 = __expf(fminf(-B0, 85.f)), ek1 = __expf(fminf(-B1, 85.f));
                const float qt0 = bf_lo(qq[j]) * eq0, qt1 = bf_hi(qq[j]) * eq1;
                kh0[j] = k0[j] * ek0; kh1[j] = k1[j] * ek1;
                const int rr = 8 * tg + j;
                *(LAS unsigned*)(buf + SC_QT + rr * 272 + ch0 * 2) = pk_bf16(qt0, qt1);
                *(LAS unsigned*)(buf + SC_KH + rr * 272 + ch0 * 2) = pk_bf16(kh0[j], kh1[j]);
                if (sample) { int pos = c * 32 + rr; if (dir) pos = T - 1 - pos;
                    *(unsigned*)(F.QH + ((size_t)dir * 4096 + bseq * 2048 + pos) * 1024 + h * 128 + ch0) = pk_bf16(qt0 * ep0, qt1 * ep1); }
            }
#pragma unroll
            for (int j = 0; j < 4; ++j) { kt0[j] = pk_bf16(kh0[2 * j], kh0[2 * j + 1]); kt1[j] = pk_bf16(kh1[2 * j], kh1[2 * j + 1]);
                vt0[j] = (vv[2 * j] & 0xffffu) | (vv[2 * j + 1] << 16); vt1[j] = (vv[2 * j] >> 16) | (vv[2 * j + 1] & 0xffff0000u); }
            *(LAS u32x4*)(buf + SC_KT + ch0 * 80 + 16 * tg) = (u32x4){kt0[0], kt0[1], kt0[2], kt0[3]};
            *(LAS u32x4*)(buf + SC_KT + (ch0 + 1) * 80 + 16 * tg) = (u32x4){kt1[0], kt1[1], kt1[2], kt1[3]};
            *(LAS u32x4*)(buf + SC_VT + ch0 * 80 + 16 * tg) = (u32x4){vt0[0], vt0[1], vt0[2], vt0[3]};
            *(LAS u32x4*)(buf + SC_VT + (ch0 + 1) * 80 + 16 * tg) = (u32x4){vt1[0], vt1[1], vt1[2], vt1[3]};
            const float t0 = a00 + a01 + a02 + a03, t1 = a10 + a11 + a12 + a13; bprev0 += t0; bprev1 += t1;
            if (tg == 0) *(LAS f32x2*)(buf + SC_EB + ch0 * 4) = (f32x2){__expf(t0), __expf(t1)};
        }
#pragma unroll
        for (int j = 0; j < 8; ++j) { qq[j] = qn[j]; zz[j] = zn[j]; vv[j] = vn[j]; }
        if (c + 2 < cbeg + 8) {
#pragma unroll
            for (int j = 0; j < 8; ++j) { int pos = (c + 2) * 32 + 8 * tg + j; if (dir) pos = T - 1 - pos; const bf16_t* rowp = pcol + (size_t)(tok0 + pos) * DIN;
                qn[j] = *(const unsigned*)rowp; zn[j] = *(const unsigned*)(rowp + zoff); vn[j] = *(const unsigned*)(rowp + 3072); }
        }
        __syncthreads();
        f32x16 Pm;
#pragma unroll
        for (int i = 0; i < 16; ++i) Pm[i] = 0.f;
#pragma unroll
        for (int ks = 0; ks < 8; ++ks) {
            const bf16x8 a = *(const LAS bf16x8*)(buf + SC_KH + r * 272 + (16 * ks + 8 * hh) * 2);
            const bf16x8 bq = *(const LAS bf16x8*)(buf + SC_QT + r * 272 + (16 * ks + 8 * hh) * 2);
            Pm = MFMA32(a, bq, Pm);
        }
#pragma unroll
        for (int i = 0; i < 16; ++i) Pm[i] = (crow(i, hh) <= r) ? Pm[i] : 0.f;
        f32x16 O;
#pragma unroll
        for (int i = 0; i < 16; ++i) O[i] = 0.f;
#pragma unroll
        for (int mb = 0; mb < 4; ++mb)
#pragma unroll
            for (int s2 = 0; s2 < 2; ++s2) {
                const bf16x8 a = lds_2x8(buf + SC_QT + r * 272 + (32 * mb + 16 * s2 + 4 * hh) * 2);
                O = MFMA32(a, pack8(S[mb], s2), O);
            }
#pragma unroll
        for (int s2 = 0; s2 < 2; ++s2) {
            const bf16x8 bv = lds_2x8(buf + SC_VT + (32 * wv + r) * 80 + (16 * s2 + 4 * hh) * 2);
            O = MFMA32(pack8(Pm, s2), bv, O);
        }
#pragma unroll
        for (int mb = 0; mb < 4; ++mb) {
#pragma unroll
            for (int ks = 0; ks < 2; ++ks) {
                const bf16x8 a = *(const LAS bf16x8*)(buf + SC_KT + (32 * mb + r) * 80 + (16 * ks + 8 * hh) * 2);
                const bf16x8 bv = *(const LAS bf16x8*)(buf + SC_VT + (32 * wv + r) * 80 + (16 * ks + 8 * hh) * 2);
                S[mb] = MFMA32(a, bv, S[mb]);
            }
#pragma unroll
            for (int q4 = 0; q4 < 4; ++q4) { const f32x4 e = *(const LAS f32x4*)(buf + SC_EB + (32 * mb + 8 * q4 + 4 * hh) * 4);
#pragma unroll
                for (int j = 0; j < 4; ++j) S[mb][4 * q4 + j] *= e[j]; }
        }
#pragma unroll
        for (int i = 0; i < 16; ++i) { int pos = c * 32 + crow(i, hh); if (dir) pos = T - 1 - pos; const float ov_ = O[i] * scale, on_ = xshfl<1>(ov_); if (!(r & 1)) *(unsigned*)(obuf + (size_t)(tok0 + pos) * 1024) = pk_bf16(ov_, on_); }
    }
    float* so;
    if (!sample) so = F.out + (size_t)NTOK * D + ((size_t)((bseq * 4 + l) * 2 + dir) * 8 + h) * 16384 + 32 * wv + r;
    else { const int u = ((bseq * 2 + dir) * 8 + h) * 8 + (cbeg >> 3); so = F.SSEG + (size_t)u * 16384 + 32 * wv + r;
        if (tg == 0) *(f32x2*)(F.DSEG + (size_t)u * 128 + ch0) = (f32x2){__expf(bprev0), __expf(bprev1)}; }
#pragma unroll
    for (int mb = 0; mb < 4; ++mb)
#pragma unroll
        for (int i = 0; i < 16; ++i) so[(32 * mb + crow(i, hh)) * 128] = S[mb][i];
}

DI void p3c_correct(const Frame& F, const int l) {
    const int u = blockIdx.x; if (u >= 256) return;
    const int tid = fresh_tid(F.wave), lane = tid & 63, wave = __builtin_amdgcn_readfirstlane(tid >> 6), r = lane & 31, hh = lane >> 5;
    const int sseq = u >> 7, dir = (u >> 6) & 1, h = (u >> 3) & 7, seg = u & 7, ub = u - seg;
    {
        const int v = tid & 127, kq = tid >> 7;
        const float* st0 = F.state_in + ((size_t)((sseq * 4 + l) * 2 + dir) * 8 + h) * 16384 + v;
        float val[32];
#pragma unroll
        for (int kk = 0; kk < 32; ++kk) val[kk] = st0[(kq * 32 + kk) * 128];
        for (int j = 0; j < seg; ++j) { const float* sp = F.SSEG + (size_t)(ub + j) * 16384 + v; const float* dp = F.DSEG + (size_t)(ub + j) * 128;
#pragma unroll
            for (int kk = 0; kk < 32; ++kk) val[kk] = dp[kq * 32 + kk] * val[kk] + sp[(kq * 32 + kk) * 128]; }
#pragma unroll
        for (int g = 0; g < 4; ++g)
            *(LAS u32x4*)(F.lds + v * 272 + (kq * 32 + 8 * g) * 2) = (u32x4){pk_bf16(val[8 * g], val[8 * g + 1]), pk_bf16(val[8 * g + 2], val[8 * g + 3]), pk_bf16(val[8 * g + 4], val[8 * g + 5]), pk_bf16(val[8 * g + 6], val[8 * g + 7])};
    }
    __syncthreads();
    int posr = seg * 256 + 32 * wave + r; if (dir) posr = 2047 - posr;
    const bf16_t* qp = F.QH + ((size_t)dir * 4096 + sseq * 2048 + posr) * 1024 + h * 128 + 8 * hh;
    bf16x8 a[8];
#pragma unroll
    for (int ks = 0; ks < 8; ++ks) a[ks] = *(const bf16x8*)(qp + 16 * ks);
    bf16_t* ob = (dir ? F.OB : F.OF) + (size_t)(TP + sseq * 2048) * 1024 + h * 128 + r;
    const float scale = 0.08838834764831845f;
#pragma unroll
    for (int nb = 0; nb < 4; ++nb) {
        f32x16 acc;
#pragma unroll
        for (int i = 0; i < 16; ++i) acc[i] = 0.f;
#pragma unroll
        for (int ks = 0; ks < 8; ++ks) { const bf16x8 bv = *(const LAS bf16x8*)(F.lds + (32 * nb + r) * 272 + (16 * ks + 8 * hh) * 2); acc = MFMA32(a[ks], bv, acc); }
#pragma unroll
        for (int i = 0; i < 16; ++i) { int pos = seg * 256 + 32 * wave + crow(i, hh); if (dir) pos = 2047 - pos; const float cv_ = scale * acc[i], cn_ = xshfl<1>(cv_); if (!(r & 1)) { unsigned* op = (unsigned*)(ob + (size_t)pos * 1024 + 32 * nb); const unsigned w_ = *op; *op = pk_bf16(bf_lo(w_) + cv_, bf_hi(w_) + cn_); } }
    }
}

DI void p4_combine(const Frame& F, const int l) {
    const int tid = fresh_tid(F.wave), lane = tid & 63, wave = __builtin_amdgcn_readfirstlane(tid >> 6), c0 = lane * 16;
    for (int tok = blockIdx.x * 8 + wave; tok < NTOK; tok += gridDim.x * 8) {
        {
            const bf16_t* pf = F.OF + (size_t)tok * 1024 + c0; const bf16_t* pb = F.OB + (size_t)tok * 1024 + c0;
            const u32x4 f0 = *(const u32x4*)pf, f1 = *(const u32x4*)(pf + 8), b0 = *(const u32x4*)pb, b1 = *(const u32x4*)(pb + 8);
            f32x4 o[4]; float ss = 0.f;
#pragma unroll
            for (int j = 0; j < 4; ++j) { const unsigned fa = (j < 2) ? f0[2 * j] : f1[2 * j - 4], fb = (j < 2) ? f0[2 * j + 1] : f1[2 * j - 3], ba = (j < 2) ? b0[2 * j] : b1[2 * j - 4], bb = (j < 2) ? b0[2 * j + 1] : b1[2 * j - 3];
                o[j] = (f32x4){bf_lo(fa) + bf_lo(ba), bf_hi(fa) + bf_hi(ba), bf_lo(fb) + bf_lo(bb), bf_hi(fb) + bf_hi(bb)}; ss += o[j][0] * o[j][0] + o[j][1] * o[j][1] + o[j][2] * o[j][2] + o[j][3] * o[j][3]; }
            ss += xshfl<1>(ss); ss += xshfl<2>(ss); ss += xshfl<4>(ss);
            const float rstd = __frsqrt_rn(ss * (1.0f / 128.0f) + EPS);
            const u32x4 g0 = *(const u32x4*)(F.P + (size_t)tok * DIN + 4096 + c0), g1 = *(const u32x4*)(F.P + (size_t)tok * DIN + 4096 + c0 + 8);
            const float* gw = F.hgrn_norm_w + l * 1024 + c0;
            unsigned w[8];
#pragma unroll
            for (int j = 0; j < 4; ++j) { const f32x4 gn = *(const f32x4*)(gw + 4 * j); const unsigned ga = (j < 2) ? g0[2 * j] : g1[2 * j - 4], gb = (j < 2) ? g0[2 * j + 1] : g1[2 * j - 3];
                const float r0 = o[j][0] * rstd * gn[0] * silu_f(bf_lo(ga)), r1 = o[j][1] * rstd * gn[1] * silu_f(bf_hi(ga));
                const float r2 = o[j][2] * rstd * gn[2] * silu_f(bf_lo(gb)), r3 = o[j][3] * rstd * gn[3] * silu_f(bf_hi(gb));
                w[2 * j] = pk_bf16(r0, r1); w[2 * j + 1] = pk_bf16(r2, r3); }
            bf16_t* dst = F.CAT + (size_t)tok * D + c0;
            *(u32x4*)dst = (u32x4){w[0], w[1], w[2], w[3]}; *(u32x4*)(dst + 8) = (u32x4){w[4], w[5], w[6], w[7]};
        }
        {
            const int gi = lane >> 4, half = 1 << gi;
            int L, pos; if (tok < TP) { L = 256; pos = tok & 255; } else { L = 64; pos = (tok - TP) & 63; }
            const int sbase = tok - pos; int lo = pos - half; lo = lo < 0 ? 0 : lo; int hi = pos + half; hi = hi > L ? L : hi;
            float acc[16];
#pragma unroll
            for (int j = 0; j < 16; ++j) acc[j] = 0.f;
            const bf16_t* pu = F.P + 5120 + c0;
            for (int d0 = -half; d0 < half; d0 += 4) {
                u32x4 a[4], bq[4]; float mk[4];
#pragma unroll
                for (int u = 0; u < 4; ++u) { const int d = d0 + u, t = pos + d; const bool ok = (d < half) && (t >= 0) && (t < L); const int tt = ok ? t : pos; mk[u] = ok ? 1.f : 0.f;
                    a[u] = *(const u32x4*)(pu + (size_t)(sbase + tt) * DIN); bq[u] = *(const u32x4*)(pu + (size_t)(sbase + tt) * DIN + 8); }
#pragma unroll
                for (int u = 0; u < 4; ++u)
#pragma unroll
                    for (int j = 0; j < 4; ++j) { acc[2 * j] += mk[u] * bf_lo(a[u][j]); acc[2 * j + 1] += mk[u] * bf_hi(a[u][j]); acc[8 + 2 * j] += mk[u] * bf_lo(bq[u][j]); acc[9 + 2 * j] += mk[u] * bf_hi(bq[u][j]); } }
            const float inv = 1.0f / (float)(hi - lo);
            const u32x4 sa = *(const u32x4*)(pu + (size_t)tok * DIN), sb = *(const u32x4*)(pu + (size_t)tok * DIN + 8);
            const float* ps = F.pool_scale + l * 1024 + c0;
            unsigned w[8];
#pragma unroll
            for (int j = 0; j < 4; ++j) { const f32x4 s0 = *(const f32x4*)(ps + 4 * j);
                const unsigned ua = (j < 2) ? sa[2 * j] : sb[2 * j - 4], ub = (j < 2) ? sa[2 * j + 1] : sb[2 * j - 3];
                const float r0 = (acc[4 * j] * inv - bf_lo(ua)) * s0[0], r1 = (acc[4 * j + 1] * inv - bf_hi(ua)) * s0[1];
                const float r2 = (acc[4 * j + 2] * inv - bf_lo(ub)) * s0[2], r3 = (acc[4 * j + 3] * inv - bf_hi(ub)) * s0[3];
                w[2 * j] = pk_bf16(r0, r1); w[2 * j + 1] = pk_bf16(r2, r3); }
            bf16_t* dst = F.CAT + (size_t)tok * D + 1024 + c0;
            *(u32x4*)dst = (u32x4){w[0], w[1], w[2], w[3]}; *(u32x4*)(dst + 8) = (u32x4){w[4], w[5], w[6], w[7]};
        }
    }
}

#define CE_D(a, b) do { const float _h = fmaxf(a, b), _l = fminf(a, b); a = _h; b = _l; } while (0)
#define CE_A(a, b) do { const float _h = fmaxf(a, b), _l = fminf(a, b); a = _l; b = _h; } while (0)
template <int N> DI void bitonic_sort_desc(float* v) {
#pragma unroll
    for (int k = 2; k <= N; k <<= 1)
#pragma unroll
        for (int j = k >> 1; j > 0; j >>= 1)
#pragma unroll
            for (int i = 0; i < N; ++i) { const int x = i ^ j; if (x > i) { if ((i & k) == 0) CE_D(v[i], v[x]); else CE_A(v[i], v[x]); } }
}
template <int N> DI void bitonic_merge_desc(float* v) {
#pragma unroll
    for (int j = N >> 1; j > 0; j >>= 1)
#pragma unroll
        for (int i = 0; i < N; ++i) { const int x = i ^ j; if (x > i) CE_D(v[i], v[x]); }
}
#define CEP_D(ka, kb, pa, pb) do { const bool _s = (kb) > (ka); const float _k = _s ? (kb) : (ka); kb = _s ? (ka) : (kb); ka = _k; const unsigned _p = _s ? (pb) : (pa); pb = _s ? (pa) : (pb); pa = _p; } while (0)
#define CEP_A(ka, kb, pa, pb) do { const bool _s = (kb) < (ka); const float _k = _s ? (kb) : (ka); kb = _s ? (ka) : (kb); ka = _k; const unsigned _p = _s ? (pb) : (pa); pb = _s ? (pa) : (pb); pa = _p; } while (0)
template <int N> DI void bitonic_sort_desc_p(float* v, unsigned* p) {
#pragma unroll
    for (int k = 2; k <= N; k <<= 1)
#pragma unroll
        for (int j = k >> 1; j > 0; j >>= 1)
#pragma unroll
            for (int i = 0; i < N; ++i) { const int x = i ^ j; if (x > i) { if ((i & k) == 0) CEP_D(v[i], v[x], p[i], p[x]); else CEP_A(v[i], v[x], p[i], p[x]); } }
}
template <int N> DI void bitonic_merge_desc_p(float* v, unsigned* p) {
#pragma unroll
    for (int j = N >> 1; j > 0; j >>= 1)
#pragma unroll
        for (int i = 0; i < N; ++i) { const int x = i ^ j; if (x > i) CEP_D(v[i], v[x], p[i], p[x]); }
}
DI void p8_topk(const Frame& F, const int l, const pg8::StaticOrder& S) {
    const int tid = fresh_tid(F.wave), lane = tid & 63, wave = __builtin_amdgcn_readfirstlane(tid >> 6), r = lane & 31, hh = lane >> 5;
    pg8::Unit u;
    for (int ui = 0; S.next(ui, u); ++ui) {
        const int tile = u.pm * 8 + wave, h = u.pn; const int tok = tile * 32 + r;
        float s1[16], s2[16];
#pragma unroll 1
        for (int p = 0; p < 2; ++p) {
            const bf16_t* qrow = F.Q + (size_t)tok * D + h * 256 + p * 128 + 8 * hh;
            bf16x8 bq[8];
#pragma unroll
            for (int ks = 0; ks < 8; ++ks) bq[ks] = *(const bf16x8*)(qrow + 16 * ks);
            const bf16_t* kb = F.KEYS + ((size_t)((l * 8 + h) * 2 + p) * 128) * 128 + 8 * hh;
            float best[16];
#pragma unroll
            for (int i = 0; i < 16; ++i) best[i] = -INFINITY;
#pragma unroll 1
            for (int mb = 0; mb < 4; ++mb) {
                f32x16 acc;
#pragma unroll
                for (int i = 0; i < 16; ++i) acc[i] = 0.f;
#pragma unroll
                for (int ks = 0; ks < 8; ++ks) { const bf16x8 a = *(const bf16x8*)(kb + (size_t)(32 * mb + r) * 128 + 16 * ks); acc = MFMA32(a, bq[ks], acc); }
                float sc[16];
#pragma unroll
                for (int i = 0; i < 16; ++i) sc[i] = __uint_as_float((__float_as_uint(acc[i]) & ~127u) | (unsigned)(32 * mb + crow(i, hh)));
                bitonic_sort_desc<16>(sc);
#pragma unroll
                for (int i = 0; i < 16; ++i) best[i] = fmaxf(best[i], sc[15 - i]);
                bitonic_merge_desc<16>(best);
            }
            float pbv[16];
#pragma unroll
            for (int i = 0; i < 16; ++i) pbv[i] = xshfl<32>(best[i]);
#pragma unroll
            for (int i = 0; i < 16; ++i) best[i] = fmaxf(best[i], pbv[15 - i]);
            bitonic_merge_desc<16>(best);
            if (p == 0) {
#pragma unroll
                for (int i = 0; i < 16; ++i) s1[i] = best[i];
            } else {
#pragma unroll
                for (int i = 0; i < 16; ++i) s2[i] = best[i];
            }
        }
        float ca[16], cb[16]; unsigned ia[16], ib[16];
        const unsigned sha = hh ? 0u : 7u, shb = hh ? 7u : 0u;
#pragma unroll
        for (int i = 0; i < 16; ++i) { ca[i] = hh ? s2[i] : s1[i]; cb[i] = hh ? s1[i] : s2[i];
            ia[i] = (__float_as_uint(ca[i]) & 127u) << sha; ib[i] = (__float_as_uint(cb[i]) & 127u) << shb; }
        float cs[32]; unsigned cid[32];
        {
            int n = 0;
#pragma unroll
            for (int i = 0; i < 4; ++i)
#pragma unroll
                for (int j = i; j < 16; ++j) if ((i + 1) * (j + 1) <= 16) { float sv = ca[i] + cb[j]; if (i == j && hh) sv = -INFINITY; cs[n] = sv; cid[n] = ia[i] | ib[j]; ++n; }
#pragma unroll
            for (; n < 32; ++n) { cs[n] = -INFINITY; cid[n] = 0u; }
        }
        float tk[16]; unsigned ti[16];
#pragma unroll
        for (int i = 0; i < 16; ++i) { tk[i] = -INFINITY; ti[i] = 0u; }
#pragma unroll 1
        for (int it = 0; it < 2; ++it) {
            float ck[16]; unsigned ci[16];
#pragma unroll
            for (int i = 0; i < 16; ++i) { ck[i] = it ? cs[16 + i] : cs[i]; ci[i] = it ? cid[16 + i] : cid[i]; }
            bitonic_sort_desc_p<16>(ck, ci);
#pragma unroll
            for (int i = 0; i < 16; ++i) { const bool sw = ck[15 - i] > tk[i]; tk[i] = sw ? ck[15 - i] : tk[i]; ti[i] = sw ? ci[15 - i] : ti[i]; }
            bitonic_merge_desc_p<16>(tk, ti);
        }
        float pk_[16]; unsigned pi_[16];
#pragma unroll
        for (int i = 0; i < 16; ++i) { pk_[i] = xshfl<32>(tk[i]); pi_[i] = __float_as_uint(xshfl<32>(__uint_as_float(ti[i]))); }
        float fk[16]; unsigned fi[16]; float mx = -INFINITY;
#pragma unroll
        for (int i = 0; i < 16; ++i) { const bool sw = pk_[15 - i] > tk[i]; fk[i] = sw ? pk_[15 - i] : tk[i]; fi[i] = sw ? pi_[15 - i] : ti[i]; mx = fmaxf(mx, fk[i]); }
        float z = 0.f;
#pragma unroll
        for (int i = 0; i < 16; ++i) { fk[i] = __expf(fk[i] - mx); z += fk[i]; }
        const float iz = 1.0f / z;
        int* di = F.SELI + (size_t)tok * 128 + h * 16 + hh * 8; float* dg = F.SELG + (size_t)tok * 128 + h * 16 + hh * 8;
        *(u32x4*)di = (u32x4){fi[0], fi[1], fi[2], fi[3]}; *(u32x4*)(di + 4) = (u32x4){fi[4], fi[5], fi[6], fi[7]};
        *(f32x4*)dg = (f32x4){fk[0] * iz, fk[1] * iz, fk[2] * iz, fk[3] * iz}; *(f32x4*)(dg + 4) = (f32x4){fk[4] * iz, fk[5] * iz, fk[6] * iz, fk[7] * iz};
    }
}

constexpr int NB = 4;
DI float reduce8(const float (&p)[8], const int lane) {
    const bool b5 = lane & 32, b4 = lane & 16, b3 = lane & 8;
    float k4[4], k2[2];
#pragma unroll
    for (int i = 0; i < 4; ++i) { const float snd = b5 ? p[i] : p[i + 4], kp = b5 ? p[i + 4] : p[i]; k4[i] = kp + xshfl<32>(snd); }
#pragma unroll
    for (int i = 0; i < 2; ++i) { const float snd = b4 ? k4[i] : k4[i + 2], kp = b4 ? k4[i + 2] : k4[i]; k2[i] = kp + xshfl<16>(snd); }
    const float snd = b3 ? k2[0] : k2[1], kp = b3 ? k2[1] : k2[0];
    float t = kp + xshfl<8>(snd);
    t += xshfl<4>(t); t += xshfl<2>(t); t += xshfl<1>(t);
    return t;
}
#define CVT8(x, hi) __builtin_amdgcn_cvt_pk_f32_fp8((x), (hi))
constexpr int NT = 2;
DI float half_sum(float v) { v += xshfl<16>(v); v += xshfl<8>(v); v += xshfl<4>(v); v += xshfl<2>(v); v += xshfl<1>(v); return v; }
DI float half_max(float v) { v = fmaxf(v, xshfl<16>(v)); v = fmaxf(v, xshfl<8>(v)); v = fmaxf(v, xshfl<4>(v)); v = fmaxf(v, xshfl<2>(v)); v = fmaxf(v, xshfl<1>(v)); return v; }
DI float reduce8h(const float (&p)[8], const int lane) {
    const bool b4 = lane & 16, b3 = lane & 8, b2 = lane & 4;
    float k4[4], k2[2];
#pragma unroll
    for (int i = 0; i < 4; ++i) { const float snd = b4 ? p[i] : p[i + 4], kp = b4 ? p[i + 4] : p[i]; k4[i] = kp + xshfl<16>(snd); }
#pragma unroll
    for (int i = 0; i < 2; ++i) { const float snd = b3 ? k4[i] : k4[i + 2], kp = b3 ? k4[i + 2] : k4[i]; k2[i] = kp + xshfl<8>(snd); }
    const float snd = b2 ? k2[0] : k2[1], kp = b2 ? k2[1] : k2[0];
    float t = kp + xshfl<4>(snd);
    t += xshfl<2>(t); t += xshfl<1>(t);
    return t;
}
struct RowH { u32x4 d[2]; unsigned s; };
DI h32v blk_decode(const RowH& r, const int t) { h32v e;
#pragma unroll
    for (int dd = 0; dd < 4; ++dd)
        { const unsigned w = r.d[t][dd];
          const h2v v0 = __builtin_amdgcn_cvt_scalef32_pk_f16_fp4(w, 1.0f, 0), v1 = __builtin_amdgcn_cvt_scalef32_pk_f16_fp4(w, 1.0f, 1), v2 = __builtin_amdgcn_cvt_scalef32_pk_f16_fp4(w, 1.0f, 2), v3 = __builtin_amdgcn_cvt_scalef32_pk_f16_fp4(w, 1.0f, 3);
          e[8 * dd] = v0.x; e[8 * dd + 1] = v0.y; e[8 * dd + 2] = v1.x; e[8 * dd + 3] = v1.y; e[8 * dd + 4] = v2.x; e[8 * dd + 5] = v2.y; e[8 * dd + 6] = v3.x; e[8 * dd + 7] = v3.y; }
    return e; }
DI float blk_scale(const RowH& r, const int t) { return t ? __uint_as_float(r.s & 0xffff0000u) : __uint_as_float(r.s << 16); }
DI float dot64(const RowH& r, const h2v (&hv)[32]) {
    float tot = 0.f;
#pragma unroll
    for (int t = 0; t < 2; ++t) { const h32v e = blk_decode(r, t); float acc = 0.f;
#pragma unroll
        for (int p = 0; p < 16; ++p) acc = __builtin_amdgcn_fdot2((h2v){e[2 * p], e[2 * p + 1]}, hv[t * 16 + p], acc, false);
        tot += acc * blk_scale(r, t); }
    return tot;
}
DI float dot64i(const RowH& r, const int (&hh)[8], const int (&hl)[8], const float (&shs)[2]) {
    float tot = 0.f;
#pragma unroll
    for (int t = 0; t < 2; ++t) { int ah = 0, al = 0;
#pragma unroll
        for (int dd = 0; dd < 4; ++dd) { ah = __builtin_amdgcn_sdot8((int)r.d[t][dd], hh[t * 4 + dd], ah, false); al = __builtin_amdgcn_sdot8((int)r.d[t][dd], hl[t * 4 + dd], al, false); }
        tot += (float)(ah * 16 + al) * (blk_scale(r, t) * shs[t]); }
    return tot;
}
DI void axpy64(const RowH& r, h2v (&ov)[32], const float w) {
#pragma unroll
    for (int t = 0; t < 2; ++t) { const h32v e = blk_decode(r, t); const _Float16 ws = (_Float16)(w * blk_scale(r, t)); const h2v wv = {ws, ws};
#pragma unroll
        for (int p = 0; p < 16; ++p) ov[t * 16 + p] += (h2v){e[2 * p], e[2 * p + 1]} * wv; }
}
DI void p9_peer(const Frame& F, const int l) {
    const int tid = fresh_tid(F.wave), lane = tid & 63, wave = __builtin_amdgcn_readfirstlane(tid >> 6);
    const unsigned char* UTu = F.UTAB + (size_t)l * NEXP * ROWB; const unsigned char* VTu = F.VTAB + (size_t)l * NEXP * ROWB;
    for (int tokb = (blockIdx.x * 8 + wave) * NT; tokb < NTOK; tokb += gridDim.x * 8 * NT) {
        int lnn = lane; asm volatile("; addresses of this token pair are rebuilt here, not hoisted" : "+v"(lnn));
        const int half = lnn >> 5, lq = lnn & 31;
        LAS unsigned* listw = (LAS unsigned*)(F.lds + wave * 3072 + half * 512);
        LAS float* listg = (LAS float*)(F.lds + wave * 3072 + 1024 + half * 512);
        LAS float* actl = (LAS float*)(F.lds + wave * 3072 + 2048 + half * 512);
        const int tok = tokb + half;
        {
            LAS unsigned* keyl = (LAS unsigned*)actl;
            unsigned key[4]; float gg[4]; unsigned rk[4];
#pragma unroll
            for (int r = 0; r < 4; ++r) { const size_t ei = (size_t)tok * 128 + r * 32 + lq; key[r] = ((unsigned)F.SELI[ei] << 7) | (unsigned)(r * 32 + lq); gg[r] = F.SELG[ei]; keyl[r * 32 + lq] = key[r]; rk[r] = 0u; }
#pragma unroll 1
            for (int j = 0; j < 128; j += 4) { const u32x4 kk = *(const LAS u32x4*)(keyl + j);
#pragma unroll
                for (int q = 0; q < 4; ++q)
#pragma unroll
                    for (int r = 0; r < 4; ++r) rk[r] += (kk[q] < key[r]) ? 1u : 0u; }
#pragma unroll
            for (int r = 0; r < 4; ++r) { listw[rk[r]] = key[r] >> 7; listg[rk[r]] = gg[r]; }
        }
#define H_LOAD(buf, TABu, idv) do { const unsigned char* rp_ = TABu + (size_t)(idv) * ROWB; buf.d[0] = *(const u32x4*)(rp_ + lq * 32); buf.d[1] = *(const u32x4*)(rp_ + lq * 32 + 16); buf.s = *(const unsigned*)(rp_ + 1024 + lq * 4); } while (0)
#define H_LOAD4(buf, TABu, k) do { const u32x4 i4_ = *(const LAS u32x4*)(listw + (k)); H_LOAD(buf[0], TABu, i4_[0]); H_LOAD(buf[1], TABu, i4_[1]); H_LOAD(buf[2], TABu, i4_[2]); H_LOAD(buf[3], TABu, i4_[3]); } while (0)
        {
            RowH ra[4], rb[4];
            H_LOAD4(ra, UTu, 0);
            int hh[8], hl[8]; float shs[2];
#pragma unroll
            for (int t = 0; t < 2; ++t) {
                float hv[32]; float m = 0.f;
#pragma unroll
                for (int k = 0; k < 8; ++k) { const u32x2 a = *(const u32x2*)(F.HB + (size_t)tok * D + t * 1024 + k * 128 + lq * 4);
                    hv[4 * k] = bf_lo(a[0]); hv[4 * k + 1] = bf_hi(a[0]); hv[4 * k + 2] = bf_lo(a[1]); hv[4 * k + 3] = bf_hi(a[1]); }
#pragma unroll
                for (int i = 0; i < 32; ++i) m = fmaxf(m, fabsf(hv[i]));
                const float sh = m > 0.f ? m * (1.0f / 119.0f) : 1.0f, ih = 1.0f / sh; shs[t] = sh;
#pragma unroll
                for (int dd = 0; dd < 4; ++dd) { unsigned ph = 0u, pl = 0u;
#pragma unroll
                    for (int n = 0; n < 8; ++n) { const int q = (int)rintf(hv[8 * dd + n] * ih); const int lo = ((q + 8) & 15) - 8, hi = (q - lo) >> 4;
                        ph |= (unsigned)(hi & 15) << (4 * n); pl |= (unsigned)(lo & 15) << (4 * n); }
                    hh[t * 4 + dd] = (int)ph; hl[t * 4 + dd] = (int)pl; }
            }
#pragma unroll 1
            for (int k0 = 0; k0 < 128; k0 += 8) {
                float pp[8];
                H_LOAD4(rb, UTu, k0 + 4);
#pragma unroll
                for (int q = 0; q < 4; ++q) { pp[q] = dot64i(ra[q], hh, hl, shs); }
                if (k0 != 120) H_LOAD4(ra, UTu, k0 + 8);
#pragma unroll
                for (int q = 0; q < 4; ++q) { pp[4 + q] = dot64i(rb[q], hh, hl, shs); }
                { const float t = reduce8h(pp, lq); if ((lq & 3) == 0) actl[k0 + (((lq >> 4) & 1) * 4 + ((lq >> 3) & 1) * 2 + ((lq >> 2) & 1))] = t; }
            }
        }
        RowH va[4], vb[4];
        H_LOAD4(va, VTu, 0);
#pragma unroll
        for (int r = 0; r < 4; ++r) { const int pos = r * 32 + lq; const float act = actl[pos]; listg[pos] = listg[pos] * 0.5f * act * (1.0f + erff(act * 0.70710678118654752f)); }
        h2v o[32];
#pragma unroll
        for (int j = 0; j < 32; ++j) o[j] = (h2v){(_Float16)0.f, (_Float16)0.f};
        {
#define H_AXPY4(buf, k) do { const f32x4 w4_ = *(const LAS f32x4*)(listg + (k)); _Pragma("unroll") for (int q = 0; q < 4; ++q) { axpy64(buf[q], o, w4_[q]); __builtin_amdgcn_sched_barrier(0); } } while (0)
#pragma unroll 1
            for (int k0 = 0; k0 < 128; k0 += 8) {
                H_LOAD4(vb, VTu, k0 + 4);
                H_AXPY4(va, k0);
                if (k0 != 120) H_LOAD4(va, VTu, k0 + 8);
                H_AXPY4(vb, k0 + 4);
            }
        }
#undef H_LOAD4
#undef H_AXPY4
#undef H_LOAD
        {
            int le = lq; asm volatile("; epilogue addresses rebuilt per token" : "+v"(le));
            const int grp = (tok < TP) ? 0 : 1 + ((tok - TP) >> 11);
            const float* md = F.MOD + (size_t)(l * 3 + grp) * 12288;
            bf16_t* xr = F.XB + (size_t)tok * D + le * 4;
            f32x4 xn[16]; float ss = 0.f;
#pragma unroll
            for (int t = 0; t < 2; ++t)
#pragma unroll
                for (int k = 0; k < 8; ++k) { bf16_t* xp = xr + t * 1024 + k * 128;
                    const u32x2 xw = *(const u32x2*)xp; const f32x4 xa = {bf_lo(xw.x), bf_hi(xw.x), bf_lo(xw.y), bf_hi(xw.y)}, ga = *(const f32x4*)(md + 10240 + le * 4 + t * 1024 + k * 128);
                    const f32x4 ov = {(float)o[t * 16 + 2 * k].x, (float)o[t * 16 + 2 * k].y, (float)o[t * 16 + 2 * k + 1].x, (float)o[t * 16 + 2 * k + 1].y};
                    const f32x4 v = xa + ga * ov; xn[t * 8 + k] = v; ss += v[0] * v[0] + v[1] * v[1] + v[2] * v[2] + v[3] * v[3];
                    if (l < 3) *(u32x2*)xp = (u32x2){pk_bf16(v[0], v[1]), pk_bf16(v[2], v[3])}; }
            ss = half_sum(ss);
            const float rstd = __frsqrt_rn(ss * (1.0f / 2048.0f) + EPS);
            if (l < 3) {
                const float* nw = F.norm_w + (size_t)(l + 1) * 2 * D; const float* mn = F.MOD + (size_t)((l + 1) * 3 + grp) * 12288;
#pragma unroll
                for (int t = 0; t < 2; ++t)
#pragma unroll
                    for (int k = 0; k < 8; ++k) { const int cidx = le * 4 + t * 1024 + k * 128;
                        const f32x4 nv = *(const f32x4*)(nw + cidx), sc = *(const f32x4*)(mn + 2048 + cidx), sh = *(const f32x4*)(mn + cidx);
                        const f32x4 hv = xn[t * 8 + k] * rstd * nv * (1.0f + sc) + sh;
                        *(u32x2*)(F.HB + (size_t)tok * D + cidx) = (u32x2){pk_bf16(hv[0], hv[1]), pk_bf16(hv[2], hv[3])}; }
            } else {
                float* yo = F.out + (size_t)tok * D + le * 4;
#pragma unroll
                for (int t = 0; t < 2; ++t)
#pragma unroll
                    for (int k = 0; k < 8; ++k) { const f32x4 na = *(const f32x4*)(F.final_norm_w + le * 4 + t * 1024 + k * 128); *(f32x4*)(yo + t * 1024 + k * 128) = xn[t * 8 + k] * rstd * na; }
            }
        }
    }
}

__global__ void __launch_bounds__(512, 2) mk_fwd(Args args) {
    extern __shared__ __attribute__((aligned(16))) unsigned char lds_raw[];
    Frame F;
    F.lds = (LAS unsigned char*)lds_raw; F.tid = threadIdx.x; F.lane = F.tid & 63; F.wave = __builtin_amdgcn_readfirstlane(F.tid >> 6);
    F.x_prompt = args.in[0]; F.x_sample = args.in[1]; F.state_in = args.in[2]; F.c = args.in[3]; F.c_ctx = args.in[4]; F.w_ada = args.in[5]; F.b_ada = args.in[6]; F.norm_w = args.in[7];
    F.w_in = args.in[8]; F.lower_bounds = args.in[9]; F.hgrn_norm_w = args.in[10]; F.w_pool = args.in[11]; F.pool_scale = args.in[12]; F.w_out = args.in[13]; F.w_query = args.in[14];
    F.sub_keys = args.in[15]; F.expert_u = args.in[16]; F.expert_v = args.in[17]; F.final_norm_w = args.in[18];
    unsigned char* ws = args.ws; F.out = args.out;
    F.MOD = (float*)(ws + WS_MOD); F.LB = (float*)(ws + WS_LB); F.WIN = (bf16_t*)(ws + WS_WIN); F.WOUT = (bf16_t*)(ws + WS_WOUT); F.WQ = (bf16_t*)(ws + WS_WQ); F.WINU = (bf16_t*)(ws + WS_WINU);
    F.WPOOL = (bf16_t*)(ws + WS_WPOOL); F.KEYS = (bf16_t*)(ws + WS_KEYS); F.UTAB = ws + WS_UTAB; F.VTAB = ws + WS_VTAB; F.USC = (float*)(ws + WS_USC); F.VSC = (float*)(ws + WS_VSC); F.X = (float*)(ws + WS_X); F.XB = (bf16_t*)(ws + WS_X); F.HB = (bf16_t*)(ws + WS_HB);
    F.P = (bf16_t*)(ws + WS_P); F.OF = (bf16_t*)(ws + WS_OF); F.OB = (bf16_t*)(ws + WS_OB); F.CAT = (bf16_t*)(ws + WS_CAT); F.Q = (bf16_t*)(ws + WS_Q); F.SELI = (int*)(ws + WS_SELI); F.SELG = (float*)(ws + WS_SELG); F.MODP = (float*)(ws + WS_MODP); F.QH = (bf16_t*)(ws + WS_QH); F.SSEG = (float*)(ws + WS_SSEG); F.DSEG = (float*)(ws + WS_DSEG);
    const int lo = args.ph_lo, hi = args.ph_hi;
    volatile LAS unsigned* misc = (volatile LAS unsigned*)(F.lds + MISC_OFF);
    if (F.tid < 4) misc[F.tid] = 0u;
    __syncthreads();
    XcdBarrier bar; bar.bar = (unsigned*)(ws + WS_CTL); bar.x = 0; bar.st = misc;
    if (hi - lo > 1) bar = xcd_barrier_post((unsigned*)(ws + WS_CTL), misc);
#define IN(k) (lo <= (k) && (k) < hi)
#define SEAM(k) do { if ((k) + 1 < hi) xcd_barrier(bar); } while (0)
    const int G = gridDim.x, bx = blockIdx.x;
    if (IN(0)) { for (int rep = 0; rep < NREP(0); ++rep) { if (KIND_ON(0)) p0_prologue(F); __syncthreads(); } SEAM(0); }
    if (IN(1)) {
        if (KIND_ON(1)) {
            pg8::Gemm g{F.WPOOL, F.WINU, 4096, 32768, 256, 256, 256}; pg8::PoolFoldOrder S{G, bx}; pg8::EpiPoolFold E{F.WIN};
            pg8::gemm_phase<pg8::EpiPoolFold, pg8::PoolFoldOrder>(F.lds, g, S, E, F.wave);
        }
        if (KIND_ON(6)) {
            for (int i = bx * 512 + fresh_tid(F.wave); i < 4 * 3 * 12288; i += G * 512) F.MOD[i] = ((F.MODP[i] + F.MODP[MODP_STRIDE + i]) + F.MODP[2 * MODP_STRIDE + i]) + F.MODP[3 * MODP_STRIDE + i];
            norm_rows<4, false>(F, F.x_prompt, F.x_sample, F.norm_w, F.MODP, 0, 2048);
        }
        SEAM(1);
    }
    for (int l = 0; l < 4; ++l) {
        const int pb = 2 + 9 * l;
        if (IN(pb) && KIND_ON(2)) for (int rep = 0; rep < NREP(2); ++rep) {
            pg8::Gemm g{F.HB, F.WIN + (size_t)l * 6144 * 2048, NTOK, DIN, D, D, D}; pg8::StaticOrder S; S.init(NTOK, DIN, G, bx); pg8::EpiBf16 E{F.P, DIN};
            pg8::gemm_phase<pg8::EpiBf16, pg8::StaticOrder>(F.lds, g, S, E, F.wave);
            if (rep == NREP(2) - 1) SEAM(pb);
        }
        if (IN(pb + 1)) { for (int rep = 0; rep < NREP(3); ++rep) { if (KIND_ON(3)) p3_scan(F, l); __syncthreads(); } SEAM(pb + 1); }
        if (IN(pb + 2)) { if (KIND_ON(3)) p3c_correct(F, l); SEAM(pb + 2); }
        if (IN(pb + 3)) { for (int rep = 0; rep < NREP(4); ++rep) if (KIND_ON(4)) p4_combine(F, l); SEAM(pb + 3); }
        if (IN(pb + 4) && KIND_ON(5)) {
            pg8::Gemm g{F.CAT, F.WOUT + (size_t)l * D * D, NTOK, D, D, D, D}; pg8::StaticOrder S; S.init(NTOK, D, G, bx);
            pg8::EpiRes E{l == 0 ? F.x_prompt : nullptr, l == 0 ? F.x_sample : nullptr, l == 0 ? nullptr : F.XB, F.XB, F.MOD + (size_t)l * 3 * 12288 + 4096};
            pg8::gemm_phase<pg8::EpiRes, pg8::StaticOrder>(F.lds, g, S, E, F.wave);
            SEAM(pb + 4);
        }
        if (IN(pb + 5)) { for (int rep = 0; rep < NREP(6); ++rep) if (KIND_ON(6)) norm_rows<1, true>(F, F.XB, F.XB + (size_t)TP * D, F.norm_w + (size_t)(l * 2 + 1) * D, F.MOD + (size_t)l * 3 * 12288, 6144, 8192); SEAM(pb + 5); }
        if (IN(pb + 6) && KIND_ON(7)) {
            pg8::Gemm g{F.HB, F.WQ + (size_t)l * D * D, NTOK, D, D, D, D}; pg8::StaticOrder S; S.init(NTOK, D, G, bx); pg8::EpiBf16 E{F.Q, D};
            const bool early = (bx >> 3) & 1, odd = F.wave & 1;
#pragma unroll 1
            for (int st = 0; st < 4; ++st) {
                if (st == 1) {
                    pg8::gemm_phase<pg8::EpiBf16, pg8::StaticOrder>(F.lds, g, S, E, F.wave);
                    asm volatile("s_waitcnt vmcnt(0)" ::: "memory");
                    __syncthreads();
                    if (F.tid == 0) { __builtin_amdgcn_fence(__ATOMIC_ACQUIRE, "agent"); asm volatile("s_waitcnt vmcnt(0)" ::: "memory"); }
                    __syncthreads();
                    continue;
                }
                const bool cv = early ? (st == 0) : ((st == 2 && !odd) || (st == 3 && odd));
                const bool tk = early ? (st == 2) : ((st == 2 && odd) || (st == 3 && !odd));
                if (cv && KIND_ON(8)) conv_tables(F, l);
                if (tk && KIND_ON(8)) p8_topk(F, l, S);
            }
            SEAM(pb + 6);
        }
        if (IN(pb + 8)) { if (KIND_ON(9)) p9_peer(F, l); SEAM(pb + 8); }
    }
}

extern "C" void kernel_launch(void* const* d_in, const int* in_sizes, int n_in, void* d_out, int out_size, void* d_ws, size_t ws_size, hipStream_t stream) {
    static int grid = 0;
    if (grid == 0) {
        if (n_in != 19 || ws_size < WS_END) { fprintf(stderr, "kernel_launch: expected 19 inputs and >= %zu bytes of workspace, got %d / %zu\n", (size_t)WS_END, n_in, ws_size); grid = -1; return; }
        int dev = 0, cus = 0, per_cu = 0;
        if (hipGetDevice(&dev) != hipSuccess || hipDeviceGetAttribute(&cus, hipDeviceAttributeMultiprocessorCount, dev) != hipSuccess) { grid = -1; return; }
        if (hipFuncSetAttribute((const void*)mk_fwd, hipFuncAttributeMaxDynamicSharedMemorySize, LDS_BYTES) != hipSuccess) { fprintf(stderr, "kernel_launch: hipFuncSetAttribute failed\n"); grid = -1; return; }
        if (hipOccupancyMaxActiveBlocksPerMultiprocessor(&per_cu, (const void*)mk_fwd, 512, LDS_BYTES) != hipSuccess || per_cu < 1) { fprintf(stderr, "kernel_launch: occupancy query says %d\n", per_cu); }
        (void)hipGetLastError();
        grid = cus;
    }
    if (grid < 0) return;
    (void)hipMemsetAsync((char*)d_ws + WS_CTL, 0, WS_MOD - WS_CTL, stream);
    Args a{};
    for (int i = 0; i < 19; ++i) a.in[i] = (const float*)d_in[i];
    a.out = (float*)d_out; a.ws = (unsigned char*)d_ws;
#if MK_ONE_LAUNCH
    a.ph_lo = 0; a.ph_hi = NPHASE;
    hipLaunchKernelGGL(mk_fwd, dim3(grid), dim3(512), LDS_BYTES, stream, a);
#else
    for (int ph = 0; ph < NPHASE; ++ph) { a.ph_lo = ph; a.ph_hi = ph + 1; hipLaunchKernelGGL(mk_fwd, dim3(grid), dim3(512), LDS_BYTES, stream, a); }
#endif
}
```
